# Optimizing an MI355X kernel written in HIP

```python
import math
import jax, jax.numpy as jnp
from jax import lax
import numpy as np

D_MODEL = 2048
BATCH = 4
SEQ = 4096
DEPTH = 2

CHUNK = 64
Q_BLOCK = 128
SSM_WIDTH = 1024
SSM_GROUP = 16
SSM_GROUPS = SSM_WIDTH // SSM_GROUP
SSM_STATE = 64
ATTN_WIDTH = 1024
N_HEADS = 8
HEAD_DIM = ATTN_WIDTH // N_HEADS // 2
V_DIM = 2 * HEAD_DIM
IN_WIDTH = SSM_WIDTH + 3 * ATTN_WIDTH + 2 * D_MODEL
_FF_RAW = -(-8 * D_MODEL // 3)
D_FF = -(-_FF_RAW // 256) * 256
N_BUCKETS = 32
MAX_DISTANCE = 128
RMS_EPS = 1e-6
SUBLN_EPS = 1e-5

kernel_name = "hybrid_s5_diffattn_gated_block"


def rms_norm(x, w, eps):
    xf = x.astype(jnp.float32)
    y = xf * lax.rsqrt(jnp.mean(xf * xf, axis=-1, keepdims=True) + eps)
    return (y * w.astype(jnp.float32)).astype(x.dtype)


def t5_bucket(rel):
    nb = N_BUCKETS // 2
    ret = jnp.where(rel > 0, nb, 0)
    n = jnp.abs(rel)
    max_exact = nb // 2
    nf = jnp.maximum(n, 1).astype(jnp.float32)
    large = max_exact + (jnp.log(nf / max_exact) / math.log(MAX_DISTANCE / max_exact)
                         * (nb - max_exact)).astype(jnp.int32)
    large = jnp.minimum(large, nb - 1)
    return ret + jnp.where(n < max_exact, n, large)


def _complex_linear_combine(e1, e2):
    ar1, ai1, br1, bi1 = e1
    ar2, ai2, br2, bi2 = e2
    ar = ar1 * ar2 - ai1 * ai2
    ai = ar1 * ai2 + ai1 * ar2
    br = ar2 * br1 - ai2 * bi1 + br2
    bi = ar2 * bi1 + ai2 * br1 + bi2
    return (ar, ai, br, bi)


def s5_mixer(u, lam_re, lam_im, log_step, b_re, b_im, c_re, c_im, d_skip, w_glu, b_glu):
    f32 = jnp.float32
    bsz, L, _ = u.shape
    ug = u.reshape(bsz, L, SSM_GROUPS, SSM_GROUP).astype(f32)
    lr = jnp.minimum(lam_re.astype(f32), -1e-4)
    li = lam_im.astype(f32)
    dt = jnp.exp(log_step.astype(f32))[:, None]
    mag = jnp.exp(lr * dt)
    ab_r = mag * jnp.cos(li * dt)
    ab_i = mag * jnp.sin(li * dt)
    den = lr * lr + li * li
    nr = ab_r - 1.0
    ni = ab_i
    fr = (nr * lr + ni * li) / den
    fi = (ni * lr - nr * li) / den
    br = b_re.astype(f32)
    bi = b_im.astype(f32)
    bb_r = fr[..., None] * br - fi[..., None] * bi
    bb_i = fr[..., None] * bi + fi[..., None] * br
    bu_r = jnp.einsum('blgc,gpc->blgp', ug, bb_r)
    bu_i = jnp.einsum('blgc,gpc->blgp', ug, bb_i)
    a_r = jnp.broadcast_to(ab_r, (1, L, SSM_GROUPS, SSM_STATE))
    a_i = jnp.broadcast_to(ab_i, (1, L, SSM_GROUPS, SSM_STATE))
    _, _, s_r, s_i = lax.associative_scan(_complex_linear_combine, (a_r, a_i, bu_r, bu_i), axis=1)
    y = (jnp.einsum('blgp,gcp->blgc', s_r, c_re.astype(f32))
         - jnp.einsum('blgp,gcp->blgc', s_i, c_im.astype(f32))
         + d_skip.astype(f32).reshape(SSM_GROUPS, SSM_GROUP) * ug)
    y = jax.nn.gelu(y.reshape(bsz, L, SSM_WIDTH).astype(u.dtype))
    return y * jax.nn.sigmoid(y @ w_glu + b_glu)


def diff_attention(q, k, v, q_norm_w, k_norm_w, lq1, lk1, lq2, lk2, subln_w, rel_table, lambda_init):
    f32 = jnp.float32
    bsz, L, _ = q.shape
    q = rms_norm(q.reshape(bsz, L, N_HEADS, 2, HEAD_DIM), q_norm_w, RMS_EPS) * (HEAD_DIM ** -0.5)
    k = rms_norm(k.reshape(bsz, L, N_HEADS, 2, HEAD_DIM), k_norm_w, RMS_EPS)
    v = v.reshape(bsz, L, N_HEADS, V_DIM)
    lam = (jnp.exp(jnp.sum(lq1.astype(f32) * lk1.astype(f32)))
           - jnp.exp(jnp.sum(lq2.astype(f32) * lk2.astype(f32))) + lambda_init)
    kpos = jnp.arange(L)
    n_blocks = L // Q_BLOCK
    qb = q.reshape(bsz, n_blocks, Q_BLOCK, N_HEADS, 2, HEAD_DIM).transpose(1, 0, 2, 3, 4, 5)

    def block(args):
        q_i, i = args
        qpos = i * Q_BLOCK + jnp.arange(Q_BLOCK)
        s = jnp.einsum('bqhmd,bkhmd->bhmqk', q_i, k, preferred_element_type=f32)
        bias = rel_table[t5_bucket(kpos[None, :] - qpos[:, None])]
        bias = jnp.transpose(bias, (2, 0, 1)).astype(f32)[None, :, None]
        mask = (kpos[None, :] // CHUNK) <= (qpos[:, None] // CHUNK)
        s = jnp.where(mask, s + bias, -jnp.inf)
        p = jax.nn.softmax(s, axis=-1)
        p = p[:, :, 0] - lam * p[:, :, 1]
        return jnp.einsum('bhqk,bkhe->bqhe', p.astype(v.dtype), v)

    o = lax.map(block, (qb, jnp.arange(n_blocks)))
    o = o.transpose(1, 0, 2, 3, 4).reshape(bsz, L, N_HEADS, V_DIM)
    o = rms_norm(o, subln_w, SUBLN_EPS) * (1.0 - lambda_init)
    return o.reshape(bsz, L, ATTN_WIDTH)


def setup_inputs(seed: int = 0) -> dict:
    key = jax.random.key(seed)
    ks = jax.random.split(key, 32)
    f32 = jnp.float32
    nrm = lambda k, shape, s: jax.random.normal(k, shape, f32) * s
    lam_im0 = jnp.pi * jnp.arange(SSM_STATE, dtype=f32)
    return {
        "x": jax.random.normal(ks[0], (BATCH, SEQ, D_MODEL), f32),
        "norm1_w": 1.0 + nrm(ks[1], (DEPTH, D_MODEL), 0.02),
        "w_in": nrm(ks[2], (DEPTH, D_MODEL, IN_WIDTH), D_MODEL ** -0.5),
        "lam_re": -0.5 * jnp.exp(nrm(ks[3], (DEPTH, SSM_GROUPS, SSM_STATE), 0.05)),
        "lam_im": lam_im0 + nrm(ks[4], (DEPTH, SSM_GROUPS, SSM_STATE), 0.05),
        "log_step": jax.random.uniform(ks[5], (DEPTH, SSM_GROUPS), f32, math.log(1e-3), math.log(1e-1)),
        "ssm_b_re": nrm(ks[6], (DEPTH, SSM_GROUPS, SSM_STATE, SSM_GROUP), (2 * SSM_GROUP) ** -0.5),
        "ssm_b_im": nrm(ks[7], (DEPTH, SSM_GROUPS, SSM_STATE, SSM_GROUP), (2 * SSM_GROUP) ** -0.5),
        "ssm_c_re": nrm(ks[8], (DEPTH, SSM_GROUPS, SSM_GROUP, SSM_STATE), (2 * SSM_STATE) ** -0.5),
        "ssm_c_im": nrm(ks[9], (DEPTH, SSM_GROUPS, SSM_GROUP, SSM_STATE), (2 * SSM_STATE) ** -0.5),
        "ssm_d": nrm(ks[10], (DEPTH, SSM_WIDTH), 1.0),
        "w_glu": nrm(ks[11], (DEPTH, SSM_WIDTH, SSM_WIDTH), SSM_WIDTH ** -0.5),
        "b_glu": nrm(ks[12], (DEPTH, SSM_WIDTH), 0.02),
        "q_norm_w": 1.0 + nrm(ks[13], (DEPTH, HEAD_DIM), 0.02),
        "k_norm_w": 1.0 + nrm(ks[14], (DEPTH, HEAD_DIM), 0.02),
        "lambda_q1": nrm(ks[15], (DEPTH, HEAD_DIM), 0.1),
        "lambda_k1": nrm(ks[16], (DEPTH, HEAD_DIM), 0.1),
        "lambda_q2": nrm(ks[17], (DEPTH, HEAD_DIM), 0.1),
        "lambda_k2": nrm(ks[18], (DEPTH, HEAD_DIM), 0.1),
        "subln_w": 1.0 + nrm(ks[19], (DEPTH, V_DIM), 0.02),
        "w_proj_ssm": nrm(ks[20], (DEPTH, SSM_WIDTH, D_MODEL), SSM_WIDTH ** -0.5),
        "w_proj_attn": nrm(ks[21], (DEPTH, ATTN_WIDTH, D_MODEL), ATTN_WIDTH ** -0.5),
        "w_out": nrm(ks[22], (DEPTH, D_MODEL, D_MODEL), D_MODEL ** -0.5),
        "rel_bias": nrm(ks[23], (N_BUCKETS, N_HEADS), 0.2),
        "norm2_w": 1.0 + nrm(ks[24], (DEPTH, D_MODEL), 0.02),
        "w_ffn_gate": nrm(ks[25], (DEPTH, D_MODEL, D_FF), D_MODEL ** -0.5),
        "w_ffn_up": nrm(ks[26], (DEPTH, D_MODEL, D_FF), D_MODEL ** -0.5),
        "w_ffn_down": nrm(ks[27], (DEPTH, D_FF, D_MODEL), D_FF ** -0.5),
    }


def reference(x, norm1_w, w_in, lam_re, lam_im, log_step, ssm_b_re, ssm_b_im, ssm_c_re, ssm_c_im,
              ssm_d, w_glu, b_glu, q_norm_w, k_norm_w, lambda_q1, lambda_k1, lambda_q2, lambda_k2,
              subln_w, w_proj_ssm, w_proj_attn, w_out, rel_bias, norm2_w, w_ffn_gate, w_ffn_up,
              w_ffn_down):
    o_q = SSM_WIDTH
    o_k = o_q + ATTN_WIDTH
    o_v = o_k + ATTN_WIDTH
    o_gs = o_v + ATTN_WIDTH
    o_ga = o_gs + D_MODEL
    for l in range(DEPTH):
        lambda_init = 0.8 - 0.6 * math.exp(-0.3 * l)
        h = rms_norm(x, norm1_w[l], RMS_EPS)
        z = h @ w_in[l]
        y_ssm = s5_mixer(z[..., :o_q], lam_re[l], lam_im[l], log_step[l], ssm_b_re[l], ssm_b_im[l],
                         ssm_c_re[l], ssm_c_im[l], ssm_d[l], w_glu[l], b_glu[l])
        y_attn = diff_attention(z[..., o_q:o_k], z[..., o_k:o_v], z[..., o_v:o_gs],
                                q_norm_w[l], k_norm_w[l], lambda_q1[l], lambda_k1[l],
                                lambda_q2[l], lambda_k2[l], subln_w[l], rel_bias, lambda_init)
        m = (jax.nn.sigmoid(z[..., o_gs:o_ga]) * (y_ssm @ w_proj_ssm[l])
             + jax.nn.sigmoid(z[..., o_ga:]) * (y_attn @ w_proj_attn[l]))
        x = x + m @ w_out[l]
        h = rms_norm(x, norm2_w[l], RMS_EPS)
        x = x + (jax.nn.silu(h @ w_ffn_gate[l]) * (h @ w_ffn_up[l])) @ w_ffn_down[l]
    return x
```

```cpp
#include <hip/hip_runtime.h>
#include <hip/hip_cooperative_groups.h>
#include <cstdio>
#include <cstdint>
namespace cg = cooperative_groups;

typedef unsigned short bf16_t;
typedef short bf16x8 __attribute__((ext_vector_type(8)));
typedef float f32x4 __attribute__((ext_vector_type(4)));
typedef unsigned u32x4 __attribute__((ext_vector_type(4)));
typedef unsigned u32x2 __attribute__((ext_vector_type(2)));
#define LAS __attribute__((address_space(3)))
#define DI __device__ __forceinline__

constexpr int NB = 4, SEQ = 4096, MTOK = NB * SEQ, DM = 2048, NIN = 8192, DFF = 5632, NGU = 2 * DFF;
constexpr size_t MiB = 1u << 20;
constexpr size_t WS_WIN = 0, WS_WGLU = 32 * MiB, WS_WM = 34 * MiB, WS_WOUT = 42 * MiB, WS_WGU = 50 * MiB, WS_WDN = 94 * MiB;
constexpr size_t WS_XB = 116 * MiB;
constexpr size_t WS_Z = 180 * MiB;
constexpr size_t ZBLK = (size_t)MTOK * 1024;
constexpr size_t WS_MB = 212 * MiB;
constexpr size_t WS_ACT = 180 * MiB;
constexpr size_t WS_YG = 436 * MiB;
constexpr size_t WS_YY = 468 * MiB;
constexpr size_t WS_VT = 532 * MiB;
constexpr size_t WS_SSMM = 564 * MiB;
constexpr size_t WS_ROWSS = 580 * MiB;
constexpr size_t WS_CTL = 581 * MiB, CTL_BYTES = 16384;
constexpr size_t WS_END = 582 * MiB;
constexpr int LDS_BYTES = 147456, LDS_MISC = 147392;

struct Params {
    const float* in[28];
    float* out;
    unsigned char* ws;
    int ph_lo, ph_hi;
};

typedef const __attribute__((address_space(4))) Params* PP;
typedef unsigned u64;
constexpr float RS_SCALE = 4096.f, RS_INV = 1.f / 4096.f;
DI unsigned cvt_pk_bf16(float lo, float hi) { unsigned r; asm volatile("v_cvt_pk_bf16_f32 %0, %1, %2" : "=v"(r) : "v"(lo), "v"(hi)); return r; }
DI float bf_lo(unsigned w) { return __uint_as_float(w << 16); }
DI float bf_hi(unsigned w) { return __uint_as_float(w & 0xffff0000u); }
DI float sigm(float x) { return __builtin_amdgcn_rcpf(1.f + __expf(-x)); }
DI void unpack8(const u32x4 w, float* f) { f[0] = bf_lo(w.x); f[1] = bf_hi(w.x); f[2] = bf_lo(w.y); f[3] = bf_hi(w.y); f[4] = bf_lo(w.z); f[5] = bf_hi(w.z); f[6] = bf_lo(w.w); f[7] = bf_hi(w.w); }
#define LDS_WAIT() asm volatile("s_waitcnt lgkmcnt(0)" ::: "memory")

namespace pg8 {
#define PG8_LAS __attribute__((address_space(3)))
constexpr int BM = 256, BK = 64, HALF = 128, HTB = HALF * BK * 2, NXCD = 8, WGM = 8;
__host__ __device__ __forceinline__ int lds_byte(int r, int c) { const int st = (r >> 4) * 2 + (c >> 5), rr = r & 15, cc = c & 31, ob = rr * 64 + cc * 2; return st * 1024 + (ob ^ (((ob >> 9) & 1) << 5)); }
__host__ __device__ __forceinline__ void stage_rc(int b, int& R, int& C) { const int st = b / 1024, sb = b % 1024, swz = sb ^ (((sb >> 9) & 1) << 5); R = (st >> 1) * 16 + swz / 64; C = (st & 1) * 32 + (swz % 64) / 2; }
__host__ __device__ __forceinline__ int perm32(int rho) { const int n = rho >> 4, i = rho & 15; return 8 * (i >> 2) + 4 * n + (i & 3); }
struct Unit { int pm, pn; };
struct Gemm { const bf16_t* A; const bf16_t* Bt; int M, N, K, lda, ldb; };
struct StaticOrder {
    int nM, nN, nwg, G, c;
    __device__ void init(int M, int N, int G_, int c_) { nM = M / BM; nN = N / BM; nwg = nM * nN; G = G_; c = c_; }
    __device__ bool next(int i, Unit& u) const {
        const long L = (long)i * G + c; if (L >= nwg) return false;
        int wgid = (int)L; { const int q = nwg / NXCD, r = nwg % NXCD, xcd = wgid % NXCD, off = wgid / NXCD; wgid = (xcd < r ? xcd * (q + 1) : r * (q + 1) + (xcd - r) * q) + off; }
        const int nig = WGM * nN, gid = wgid / nig, fm = gid * WGM, gsz = (nM - fm) < WGM ? (nM - fm) : WGM;
        u.pm = fm + ((wgid % nig) % gsz); u.pn = (wgid % nig) / gsz; return true;
    }
};
template <class Epi, class Sched>
__device__ __forceinline__ void gemm_phase(PG8_LAS unsigned char* lds, const Gemm g, const Sched& S, const Epi& E) {
    int tid = threadIdx.x; asm volatile("" : "+v"(tid));
    const int wid = __builtin_amdgcn_readfirstlane(tid >> 6), lane = tid & 63, wr = wid >> 2, wc = wid & 3, fr = lane & 15, fq = lane >> 4;
    const int K = g.K, nt = K / BK;
    unsigned voffA[2], voffB[2];
#pragma unroll
    for (int i = 0; i < 2; ++i) { int R, C; stage_rc(tid * 16 + i * 8192, R, C); const int Rb = (R & ~31) + perm32(R & 31);
        voffA[i] = (unsigned)(R * g.lda + C) * 2u; voffB[i] = (unsigned)(Rb * g.ldb + C) * 2u; }
    const size_t kstep = (size_t)(BK * 2);
    const size_t hstepA = (size_t)HALF * g.lda * 2, hstepB = (size_t)HALF * g.ldb * 2;
    const size_t tstepA = 2 * hstepA, tstepB = 2 * hstepB;
    const unsigned ldsw = (unsigned)wid * 1024u;
    const int aoff = lds_byte(wr * 64 + fr, fq * 8), boff = lds_byte(wc * 32 + fr, fq * 8);
#define PG8_SA(b, h) (((b) * 2 + (h)) * HTB)
#define PG8_SB(b, h) ((4 + (b) * 2 + (h)) * HTB)
#define PG8_STAGE(bufoff, gbase, voff) do { _Pragma("unroll") for (int _i = 0; _i < 2; ++_i) \
        __builtin_amdgcn_global_load_lds((const unsigned*)((const char*)(gbase) + (voff)[_i]), (PG8_LAS unsigned*)(lds + (bufoff) + ldsw + _i * 8192), 16, 0, 0); } while (0)
#define PG8_LDA(dst, b, h) do { _Pragma("unroll") for (int m = 0; m < 4; ++m) _Pragma("unroll") for (int k = 0; k < 2; ++k) dst[m][k] = *(const PG8_LAS bf16x8*)(lds + PG8_SA(b, h) + aoff + m * 2048 + k * 1024); } while (0)
#define PG8_LDB(dst, b, h) do { _Pragma("unroll") for (int n = 0; n < 2; ++n) _Pragma("unroll") for (int k = 0; k < 2; ++k) dst[n][k] = *(const PG8_LAS bf16x8*)(lds + PG8_SB(b, h) + boff + n * 2048 + k * 1024); } while (0)
#define PG8_MMA(ai, bj, At, Bt) do { __builtin_amdgcn_s_setprio(1); _Pragma("unroll") for (int m = 0; m < 4; ++m) _Pragma("unroll") for (int n = 0; n < 2; ++n) _Pragma("unroll") for (int k = 0; k < 2; ++k) \
        acc[ai][bj][m][n] = __builtin_amdgcn_mfma_f32_16x16x32_bf16(Bt[n][k], At[m][k], acc[ai][bj][m][n], 0, 0, 0); __builtin_amdgcn_s_setprio(0); } while (0)
#define PG8_WAIT_V(n) asm volatile("s_waitcnt vmcnt(" #n ")" ::: "memory")
#define PG8_WAIT_L(n) asm volatile("s_waitcnt lgkmcnt(" #n ")" ::: "memory")
#define PG8_BAR __builtin_amdgcn_s_barrier()
#define PG8_SCHED __builtin_amdgcn_sched_barrier(0)
    Unit cur, nxt; int ui = 0;
    if (!S.next(0, cur)) return;
    f32x4 acc[2][2][4][2];
#pragma unroll
    for (int a = 0; a < 2; ++a)
#pragma unroll
        for (int b = 0; b < 2; ++b)
#pragma unroll
            for (int m = 0; m < 4; ++m)
#pragma unroll
                for (int n = 0; n < 2; ++n) acc[a][b][m][n] = (f32x4){0.f, 0.f, 0.f, 0.f};
    bf16x8 At[4][2], B0[2][2], B1[2][2];
    const char* cA = (const char*)g.A + (size_t)cur.pm * tstepA; const char* cB = (const char*)g.Bt + (size_t)cur.pn * tstepB;
    PG8_STAGE(PG8_SB(0, 0), cB, voffB); PG8_STAGE(PG8_SB(0, 1), cB + hstepB, voffB); PG8_STAGE(PG8_SA(0, 0), cA, voffA); PG8_STAGE(PG8_SA(0, 1), cA + hstepA, voffA);
    if (wr == 1) PG8_BAR;
    PG8_WAIT_V(2); PG8_BAR;
    PG8_STAGE(PG8_SB(1, 0), cB + kstep, voffB); PG8_STAGE(PG8_SA(1, 0), cA + kstep, voffA); PG8_STAGE(PG8_SB(1, 1), cB + hstepB + kstep, voffB);
    PG8_WAIT_V(6); PG8_BAR;
    for (;;) {
        const bool has_next = S.next(ui + 1, nxt);
        const char* nA = has_next ? (const char*)g.A + (size_t)nxt.pm * tstepA : cA; const char* nB = has_next ? (const char*)g.Bt + (size_t)nxt.pn * tstepB : cB;
        for (int t = 0; t < nt; t += 2) {
            const bool last = (t == nt - 2);
            const char* a1 = cA + (size_t)(t + 1) * kstep;
            const char* a2 = last ? nA : cA + (size_t)(t + 2) * kstep; const char* b2 = last ? nB : cB + (size_t)(t + 2) * kstep;
            const char* a3 = a2 + kstep; const char* b3 = b2 + kstep;
            PG8_LDB(B0, 0, 0); PG8_LDB(B1, 0, 1); PG8_SCHED; PG8_LDA(At, 0, 0); PG8_STAGE(PG8_SA(1, 1), a1 + hstepA, voffA);
            PG8_WAIT_V(8); PG8_WAIT_L(0); PG8_BAR; PG8_MMA(0, 0, At, B0); PG8_MMA(0, 1, At, B1); PG8_BAR; PG8_SCHED;
            PG8_LDA(At, 0, 1); PG8_STAGE(PG8_SB(0, 0), b2, voffB); PG8_STAGE(PG8_SB(0, 1), b2 + hstepB, voffB); PG8_STAGE(PG8_SA(0, 0), a2, voffA);
            PG8_WAIT_V(8); PG8_WAIT_L(0); PG8_BAR; PG8_MMA(1, 0, At, B0); PG8_MMA(1, 1, At, B1); PG8_BAR; PG8_SCHED;
            PG8_LDB(B0, 1, 0); PG8_LDB(B1, 1, 1); PG8_SCHED; PG8_LDA(At, 1, 0); PG8_STAGE(PG8_SA(0, 1), a2 + hstepA, voffA);
            PG8_WAIT_V(8); PG8_WAIT_L(0); PG8_BAR; PG8_MMA(0, 0, At, B0); PG8_MMA(0, 1, At, B1); PG8_BAR; PG8_SCHED;
            PG8_LDA(At, 1, 1); PG8_STAGE(PG8_SB(1, 0), b3, voffB); PG8_STAGE(PG8_SB(1, 1), b3 + hstepB, voffB); PG8_STAGE(PG8_SA(1, 0), a3, voffA);
            PG8_WAIT_V(8); PG8_WAIT_L(0); PG8_BAR; PG8_MMA(1, 0, At, B0); PG8_MMA(1, 1, At, B1); PG8_BAR; PG8_SCHED;
        }
        if (wr == 0) PG8_BAR;
        E(acc, cur, wr, wc, fr, fq);
        if (!has_next) break;
#pragma unroll
        for (int a = 0; a < 2; ++a)
#pragma unroll
            for (int b = 0; b < 2; ++b)
#pragma unroll
                for (int m = 0; m < 4; ++m)
#pragma unroll
                    for (int n = 0; n < 2; ++n) acc[a][b][m][n] = (f32x4){0.f, 0.f, 0.f, 0.f};
        cur = nxt; cA = nA; cB = nB; ++ui;
        if (wr == 1) PG8_BAR;
    }
    PG8_WAIT_V(0);
    PG8_BAR;
#undef PG8_SA
#undef PG8_SB
#undef PG8_STAGE
#undef PG8_LDA
#undef PG8_LDB
#undef PG8_MMA
#undef PG8_WAIT_V
#undef PG8_WAIT_L
#undef PG8_BAR
#undef PG8_SCHED
}
}
typedef f32x4 AccT[2][2][4][2];

struct EpiIn {
    bf16_t* Z; const u64* rowss; float* xch; const float* qw; const float* kw;
    DI void operator()(const AccT& acc, const pg8::Unit& u, int wr, int wc, int fr, int fq) const {
        const int row0 = u.pm * 256 + wr * 64 + fr, colt = u.pn * 256, blk = colt >> 10;
        bf16_t* base = Z + (size_t)blk * ZBLK + (colt & 1023) + wc * 32 + 8 * fq;
        const bool gate = blk >= 4;
        float rsv[8];
#pragma unroll
        for (int k = 0; k < 8; ++k) rsv[k] = (float)rowss[row0 + (k >> 2) * 128 + (k & 3) * 16] * RS_INV;
        if (blk == 1 || blk == 2) {
            const int wave = wr * 4 + wc;
            float part[16];
#pragma unroll
            for (int ai = 0; ai < 2; ++ai)
#pragma unroll
                for (int m = 0; m < 4; ++m) {
                    const float rs = rsqrtf(rsv[ai * 4 + m] * (1.f / DM) + 1e-6f);
                    rsv[ai * 4 + m] = rs;
#pragma unroll
                    for (int bj = 0; bj < 2; ++bj) {
                        const f32x4 v0 = acc[ai][bj][m][0] * rs, v1 = acc[ai][bj][m][1] * rs;
                        float ss = (v0[0] * v0[0] + v0[1] * v0[1]) + (v0[2] * v0[2] + v0[3] * v0[3]) + (v1[0] * v1[0] + v1[1] * v1[1]) + (v1[2] * v1[2] + v1[3] * v1[3]);
                        ss += __shfl_xor(ss, 16); ss += __shfl_xor(ss, 32);
                        part[(ai * 4 + m) * 2 + bj] = ss;
                    }
                }
            if (fq == 0) {
#pragma unroll
                for (int i = 0; i < 16; ++i) xch[(wave * 16 + i) * 16 + fr] = part[i];
            }
            asm volatile("s_waitcnt lgkmcnt(0)\n\ts_barrier" ::: "memory");
            const float* wsrc = (blk == 1 ? qw : kw) + (wc & 1) * 32 + 8 * fq;
            const float wsc = (blk == 1) ? 0.125f * 1.4426950408889634f : 1.f;
            const f32x4 w0 = *(const f32x4*)wsrc * wsc, w1 = *(const f32x4*)(wsrc + 4) * wsc;
#pragma unroll
            for (int ai = 0; ai < 2; ++ai)
#pragma unroll
                for (int m = 0; m < 4; ++m) {
                    const int row = row0 + ai * 128 + m * 16;
#pragma unroll
                    for (int bj = 0; bj < 2; ++bj) {
                        const int i = (ai * 4 + m) * 2 + bj;
                        const float tot = part[i] + xch[((wave ^ 1) * 16 + i) * 16 + fr];
                        const float sc = rsqrtf(tot * (1.f / 64.f) + 1e-6f) * rsv[ai * 4 + m];
                        const f32x4 v0 = acc[ai][bj][m][0] * sc * w0, v1 = acc[ai][bj][m][1] * sc * w1;
                        u32x4 w; w.x = cvt_pk_bf16(v0[0], v0[1]); w.y = cvt_pk_bf16(v0[2], v0[3]); w.z = cvt_pk_bf16(v1[0], v1[1]); w.w = cvt_pk_bf16(v1[2], v1[3]);
                        *(u32x4*)(base + (size_t)row * 1024 + bj * 128) = w;
                    }
                }
            return;
        }
#pragma unroll
        for (int ai = 0; ai < 2; ++ai)
#pragma unroll
            for (int m = 0; m < 4; ++m) {
                const int row = row0 + ai * 128 + m * 16;
                const float rs = rsqrtf(rsv[ai * 4 + m] * (1.f / DM) + 1e-6f);
#pragma unroll
                for (int bj = 0; bj < 2; ++bj) {
                    f32x4 v0 = acc[ai][bj][m][0] * rs, v1 = acc[ai][bj][m][1] * rs;
                    if (gate) {
#pragma unroll
                        for (int j = 0; j < 4; ++j) { v0[j] = fmaxf(sigm(v0[j]), 0.f); v1[j] = fmaxf(sigm(v1[j]), 0.f); }
                    }
                    u32x4 w; w.x = cvt_pk_bf16(v0[0], v0[1]); w.y = cvt_pk_bf16(v0[2], v0[3]); w.z = cvt_pk_bf16(v1[0], v1[1]); w.w = cvt_pk_bf16(v1[2], v1[3]);
                    *(u32x4*)(base + (size_t)row * 1024 + bj * 128) = w;
                }
            }
    }
};
struct EpiGlu {
    const bf16_t* YG; const float* bias; bf16_t* YY;
    DI void operator()(const AccT& acc, const pg8::Unit& u, int wr, int wc, int fr, int fq) const {
        const int row0 = u.pm * 256 + wr * 64 + fr, col0 = u.pn * 256 + wc * 32 + 8 * fq;
#pragma unroll
        for (int bj = 0; bj < 2; ++bj) {
            const int col = col0 + bj * 128;
            const f32x4 b0 = *(const f32x4*)(bias + col), b1 = *(const f32x4*)(bias + col + 4);
            u32x4 yv[8];
#pragma unroll
            for (int k = 0; k < 8; ++k) yv[k] = *(const u32x4*)(YG + (size_t)(row0 + (k >> 2) * 128 + (k & 3) * 16) * 1024 + col);
#pragma unroll
            for (int ai = 0; ai < 2; ++ai)
#pragma unroll
                for (int m = 0; m < 4; ++m) {
                    const int row = row0 + ai * 128 + m * 16;
                    float y[8]; unpack8(yv[ai * 4 + m], y);
                    const f32x4 a0 = acc[ai][bj][m][0] + b0, a1 = acc[ai][bj][m][1] + b1;
                    float o[8];
#pragma unroll
                    for (int j = 0; j < 4; ++j) { o[j] = y[j] * sigm(a0[j]); o[4 + j] = y[4 + j] * sigm(a1[j]); }
                    u32x4 w; w.x = cvt_pk_bf16(o[0], o[1]); w.y = cvt_pk_bf16(o[2], o[3]); w.z = cvt_pk_bf16(o[4], o[5]); w.w = cvt_pk_bf16(o[6], o[7]);
                    *(u32x4*)(YY + (size_t)row * 2048 + col) = w;
                }
        }
    }
};
struct EpiMerge {
    const bf16_t* G; bf16_t* MB; int second;
    DI void operator()(const AccT& acc, const pg8::Unit& u, int wr, int wc, int fr, int fq) const {
        const int row0 = u.pm * 256 + wr * 64 + fr, col0 = u.pn * 256 + wc * 32 + 8 * fq;
#pragma unroll
        for (int bj = 0; bj < 2; ++bj) {
            const int col = col0 + bj * 128;
            const bf16_t* gb = G + (size_t)(col >> 10) * ZBLK + (col & 1023);
#pragma unroll
            for (int ai = 0; ai < 2; ++ai) {
                u32x4 gv[4], pvv[4];
#pragma unroll
                for (int m = 0; m < 4; ++m) gv[m] = *(const u32x4*)(gb + (size_t)(row0 + ai * 128 + m * 16) * 1024);
                if (second) {
#pragma unroll
                    for (int m = 0; m < 4; ++m) pvv[m] = *(const u32x4*)(MB + (size_t)(row0 + ai * 128 + m * 16) * 2048 + col);
                }
#pragma unroll
                for (int m = 0; m < 4; ++m) {
                    const int row = row0 + ai * 128 + m * 16;
                    float gt[8]; unpack8(gv[m], gt);
                    float o[8];
#pragma unroll
                    for (int j = 0; j < 4; ++j) { o[j] = gt[j] * acc[ai][bj][m][0][j]; o[4 + j] = gt[4 + j] * acc[ai][bj][m][1][j]; }
                    if (second) { float pv[8]; unpack8(pvv[m], pv);
#pragma unroll
                        for (int j = 0; j < 8; ++j) o[j] += pv[j]; }
                    u32x4 w; w.x = cvt_pk_bf16(o[0], o[1]); w.y = cvt_pk_bf16(o[2], o[3]); w.z = cvt_pk_bf16(o[4], o[5]); w.w = cvt_pk_bf16(o[6], o[7]);
                    *(u32x4*)(MB + (size_t)row * 2048 + col) = w;
                }
            }
        }
    }
};
struct EpiRes {
    const float* xold; float* out; bf16_t* XB; u64* rowss; int emit;
    DI void operator()(const AccT& acc, const pg8::Unit& u, int wr, int wc, int fr, int fq) const {
        const int row0 = u.pm * 256 + wr * 64 + fr, col0 = u.pn * 256 + wc * 32 + 8 * fq;
#pragma unroll
        for (int ai = 0; ai < 2; ++ai) {
            f32x4 xv[4][2][2];
#pragma unroll
            for (int m = 0; m < 4; ++m)
#pragma unroll
                for (int bj = 0; bj < 2; ++bj) { const size_t off = (size_t)(row0 + ai * 128 + m * 16) * DM + col0 + bj * 128;
                    xv[m][bj][0] = *(const f32x4*)(xold + off); xv[m][bj][1] = *(const f32x4*)(xold + off + 4); }
#pragma unroll
            for (int m = 0; m < 4; ++m) {
                const int row = row0 + ai * 128 + m * 16;
                float ss = 0.f;
#pragma unroll
                for (int bj = 0; bj < 2; ++bj) {
                    const size_t off = (size_t)row * DM + col0 + bj * 128;
                    const f32x4 x0 = xv[m][bj][0] + acc[ai][bj][m][0], x1 = xv[m][bj][1] + acc[ai][bj][m][1];
                    *(f32x4*)(out + off) = x0; *(f32x4*)(out + off + 4) = x1;
                    if (emit) {
                        u32x4 w; w.x = cvt_pk_bf16(x0[0], x0[1]); w.y = cvt_pk_bf16(x0[2], x0[3]); w.z = cvt_pk_bf16(x1[0], x1[1]); w.w = cvt_pk_bf16(x1[2], x1[3]);
                        *(u32x4*)(XB + off) = w;
                        ss += (x0[0] * x0[0] + x0[1] * x0[1]) + (x0[2] * x0[2] + x0[3] * x0[3]) + (x1[0] * x1[0] + x1[1] * x1[1]) + (x1[2] * x1[2] + x1[3] * x1[3]);
                    }
                }
                if (emit) {
                    ss += __shfl_xor(ss, 16); ss += __shfl_xor(ss, 32);
                    if (fq == 0) atomicAdd(rowss + row, (u64)(ss * RS_SCALE + 0.5f));
                }
            }
        }
    }
};
struct EpiUp {
    const u64* rowss; bf16_t* ACT;
    DI void operator()(const AccT& acc, const pg8::Unit& u, int wr, int wc, int fr, int fq) const {
        const int row0 = u.pm * 256 + wr * 64 + fr, ff0 = u.pn * 128 + wc * 32 + 8 * fq;
        float rsv[8];
#pragma unroll
        for (int k = 0; k < 8; ++k) rsv[k] = (float)rowss[row0 + (k >> 2) * 128 + (k & 3) * 16] * RS_INV;
#pragma unroll
        for (int ai = 0; ai < 2; ++ai)
#pragma unroll
            for (int m = 0; m < 4; ++m) {
                const int row = row0 + ai * 128 + m * 16;
                const float rs = rsqrtf(rsv[ai * 4 + m] * (1.f / DM) + 1e-6f);
                float o[8];
#pragma unroll
                for (int n = 0; n < 2; ++n) {
                    const f32x4 gv = acc[ai][0][m][n] * rs, uv = acc[ai][1][m][n] * rs;
#pragma unroll
                    for (int j = 0; j < 4; ++j) o[4 * n + j] = gv[j] * sigm(gv[j]) * uv[j];
                }
                u32x4 w; w.x = cvt_pk_bf16(o[0], o[1]); w.y = cvt_pk_bf16(o[2], o[3]); w.z = cvt_pk_bf16(o[4], o[5]); w.w = cvt_pk_bf16(o[6], o[7]);
                *(u32x4*)(ACT + (size_t)row * DFF + ff0) = w;
            }
    }
};

DI float wave_sum(float v) {
#pragma unroll
    for (int o = 1; o < 64; o <<= 1) v += __shfl_xor(v, o);
    return v;
}
DI void tr_item(const float* W, int N, const float* scale, bf16_t* WT, int ldk, int koff, int gu, int which, float* scr, int item, int lane) {
    const int nblk = N >> 6, kb = item / nblk, nb = item - kb * nblk, k0 = 64 * kb, n0 = 64 * nb;
    const int lr = lane >> 4, lc = (lane & 15) * 4;
    f32x4 v[16];
#pragma unroll
    for (int i = 0; i < 16; ++i) v[i] = *(const f32x4*)(W + (size_t)(k0 + 4 * i + lr) * N + n0 + lc);
#pragma unroll
    for (int i = 0; i < 16; ++i) { const int kk = 4 * i + lr; const float sc = scale ? scale[k0 + kk] : 1.f; float* d = scr + kk * 65 + lc;
        d[0] = v[i].x * sc; d[1] = v[i].y * sc; d[2] = v[i].z * sc; d[3] = v[i].w * sc; }
    LDS_WAIT();
    const int c = lane & 7;
#pragma unroll
    for (int j = 0; j < 8; ++j) { const int n = (lane >> 3) + 8 * j; const float* s = scr + (8 * c) * 65 + n;
        u32x4 o; o.x = cvt_pk_bf16(s[0 * 65], s[1 * 65]); o.y = cvt_pk_bf16(s[2 * 65], s[3 * 65]); o.z = cvt_pk_bf16(s[4 * 65], s[5 * 65]); o.w = cvt_pk_bf16(s[6 * 65], s[7 * 65]);
        const int nn = n0 + n; const int drow = gu ? (((nn >> 7) << 8) + which * 128 + (nn & 127)) : nn;
        *(u32x4*)(WT + (size_t)drow * ldk + koff + k0 + 8 * c) = o; }
    LDS_WAIT();
}

constexpr size_t SSM_GRP_BYTES = 262144, SSM_KC_OFF = 65536;
DI void ssm_build(PP P, int l, unsigned char* lds, int g, int cq, int tid) {
    float* PWr = (float*)lds; float* PWi = PWr + 17 * 64; float* BBr = PWi + 17 * 64; float* BBi = BBr + 1024; float* Cr = BBi + 1024; float* Ci = Cr + 1024; float* KT = Ci + 1024; float* Dk = KT + 4096;
    __syncthreads();
    if (tid < 64) {
        const int p = tid; const size_t gp = ((size_t)l * 64 + g) * 64 + p;
        const float lr = fminf(P->in[3][gp], -1e-4f), li = P->in[4][gp], dt = expf(P->in[5][l * 64 + g]);
        const float mag = expf(lr * dt), abr = mag * cosf(li * dt), abi = mag * sinf(li * dt);
        const float den = lr * lr + li * li, nr = abr - 1.f, ni = abi;
        const float fr = (nr * lr + ni * li) / den, fi = (ni * lr - nr * li) / den;
        float pr = 1.f, pi = 0.f;
        for (int d = 0; d < 17; ++d) { PWr[d * 64 + p] = pr; PWi[d * 64 + p] = pi; const float t = pr * abr - pi * abi; pi = pr * abi + pi * abr; pr = t; }
        for (int c = 0; c < 16; ++c) { const float br = P->in[6][gp * 16 + c], bi = P->in[7][gp * 16 + c]; BBr[p * 16 + c] = fr * br - fi * bi; BBi[p * 16 + c] = fr * bi + fi * br; }
        if (p < 16) Dk[p] = P->in[10][(size_t)l * 1024 + g * 16 + p];
    }
    for (int i = tid; i < 1024; i += 512) { Cr[i] = P->in[8][((size_t)l * 64 + g) * 1024 + i]; Ci[i] = P->in[9][((size_t)l * 64 + g) * 1024 + i]; }
    __syncthreads();
    for (int e = tid; e < 1024; e += 512) {
        const int d = e >> 6, c = (e >> 2) & 15, c2 = 4 * cq + (e & 3); float v = 0.f;
        for (int p = 0; p < 64; ++p) { const float cr = Cr[c * 64 + p], ci = Ci[c * 64 + p], pr = PWr[d * 64 + p], pi = PWi[d * 64 + p];
            v += (cr * pr - ci * pi) * BBr[p * 16 + c2] - (cr * pi + ci * pr) * BBi[p * 16 + c2]; }
        KT[d * 256 + c * 16 + c2] = v;
    }
    __syncthreads();
    bf16_t* BP = (bf16_t*)(P->ws + WS_SSMM + (size_t)g * SSM_GRP_BYTES); bf16_t* KC = (bf16_t*)(P->ws + WS_SSMM + (size_t)g * SSM_GRP_BYTES + SSM_KC_OFF);
    for (int q = tid; q < 256 * 16; q += 512) {
        const int row = q >> 4, i2 = q & 15, i = row >> 4, c = row & 15, c0 = 4 * cq; float v[4];
#pragma unroll
        for (int k = 0; k < 4; ++k) v[k] = (i2 <= i) ? KT[(i - i2) * 256 + c * 16 + c0 + k] + ((i2 == i && c0 + k == c) ? Dk[c] : 0.f) : 0.f;
        u32x2 w; w.x = cvt_pk_bf16(v[0], v[1]); w.y = cvt_pk_bf16(v[2], v[3]);
        *(u32x2*)(KC + (size_t)row * 384 + i2 * 16 + c0) = w;
    }
    for (int q = tid; q < 256 * 4; q += 512) {
        const int row = q >> 2, col8 = 32 * cq + (q & 3) * 8, i = row >> 4, c = row & 15; const bool im = col8 >= 64; const int p0 = col8 & 63; float v[8];
#pragma unroll
        for (int k = 0; k < 8; ++k) { const float cr = Cr[c * 64 + p0 + k], ci = Ci[c * 64 + p0 + k], pr = PWr[(i + 1) * 64 + p0 + k], pi = PWi[(i + 1) * 64 + p0 + k];
            v[k] = im ? -(cr * pi + ci * pr) : (cr * pr - ci * pi); }
        u32x4 w; w.x = cvt_pk_bf16(v[0], v[1]); w.y = cvt_pk_bf16(v[2], v[3]); w.z = cvt_pk_bf16(v[4], v[5]); w.w = cvt_pk_bf16(v[6], v[7]);
        *(u32x4*)(KC + (size_t)row * 384 + 256 + col8) = w;
    }
    for (int q = tid; q < 128 * 16; q += 512) {
        const int rr = q >> 4, i2 = q & 15, c0 = 4 * cq, p = rr & 63, d = 15 - i2; const bool im = rr >= 64;
        const float pr = PWr[d * 64 + p], pi = PWi[d * 64 + p]; float v[4];
#pragma unroll
        for (int k = 0; k < 4; ++k) { const float br = BBr[p * 16 + c0 + k], bi = BBi[p * 16 + c0 + k]; v[k] = im ? (pr * bi + pi * br) : (pr * br - pi * bi); }
        u32x2 w; w.x = cvt_pk_bf16(v[0], v[1]); w.y = cvt_pk_bf16(v[2], v[3]);
        *(u32x2*)(BP + (size_t)rr * 256 + i2 * 16 + c0) = w;
    }
    __syncthreads();
}

DI void conv_phase(PP P, int l, unsigned char* lds, int G, int cid) {
    int tid = threadIdx.x; asm volatile("" : "+v"(tid));
    const int lane = tid & 63, wave = tid >> 6;
    const int gw = cid * 8 + wave, NGW = G * 8;
    float* scr = (float*)(lds + wave * 16640);
    unsigned char* ws = P->ws;
    for (int w = cid; w < 256; w += G) ssm_build(P, l, lds, w >> 2, w & 3, tid);
    constexpr int I1 = 32 * 128, I2 = 16 * 16, I3 = 16 * 32, I4 = I3, I5 = 32 * 32, I6 = 32 * 88, I7 = I6, I8 = 88 * 32;
    constexpr int NIT = I1 + I2 + I3 + I4 + I5 + I6 + I7 + I8;
    const float* n1 = P->in[1] + (size_t)l * DM; const float* n2 = P->in[24] + (size_t)l * DM;
    for (int it = gw; it < NIT; it += NGW) {
        int r = it;
        if (r < I1) { tr_item(P->in[2] + (size_t)l * DM * NIN, NIN, n1, (bf16_t*)(ws + WS_WIN), DM, 0, 0, 0, scr, r, lane); continue; } r -= I1;
        if (r < I2) { tr_item(P->in[11] + (size_t)l * 1024 * 1024, 1024, nullptr, (bf16_t*)(ws + WS_WGLU), 1024, 0, 0, 0, scr, r, lane); continue; } r -= I2;
        if (r < I3) { tr_item(P->in[20] + (size_t)l * 1024 * DM, DM, nullptr, (bf16_t*)(ws + WS_WM), 2048, 0, 0, 0, scr, r, lane); continue; } r -= I3;
        if (r < I4) { tr_item(P->in[21] + (size_t)l * 1024 * DM, DM, nullptr, (bf16_t*)(ws + WS_WM), 2048, 1024, 0, 0, scr, r, lane); continue; } r -= I4;
        if (r < I5) { tr_item(P->in[22] + (size_t)l * DM * DM, DM, nullptr, (bf16_t*)(ws + WS_WOUT), DM, 0, 0, 0, scr, r, lane); continue; } r -= I5;
        if (r < I6) { tr_item(P->in[25] + (size_t)l * DM * DFF, DFF, n2, (bf16_t*)(ws + WS_WGU), DM, 0, 1, 0, scr, r, lane); continue; } r -= I6;
        if (r < I7) { tr_item(P->in[26] + (size_t)l * DM * DFF, DFF, n2, (bf16_t*)(ws + WS_WGU), DM, 0, 1, 1, scr, r, lane); continue; } r -= I7;
        tr_item(P->in[27] + (size_t)l * DFF * DM, DM, nullptr, (bf16_t*)(ws + WS_WDN), DFF, 0, 0, 0, scr, r, lane);
    }
    if (l == 0) {
        u64* rowss = (u64*)(ws + WS_ROWSS);
        for (int i = cid * 512 + tid; i < 3 * MTOK; i += G * 512) rowss[MTOK + i] = 0u;
        const float* x = P->in[0]; bf16_t* XB = (bf16_t*)(ws + WS_XB);
        for (int m = gw; m < MTOK; m += NGW) {
            const f32x4* xr = (const f32x4*)(x + (size_t)m * DM) + lane;
            f32x4 v[8]; float s = 0.f;
#pragma unroll
            for (int j = 0; j < 8; ++j) { v[j] = xr[64 * j]; s += (v[j].x * v[j].x + v[j].y * v[j].y) + (v[j].z * v[j].z + v[j].w * v[j].w); }
            s = wave_sum(s);
            if (lane == 0) rowss[m] = (u64)(s * RS_SCALE + 0.5f);
            u32x2* o = (u32x2*)(XB + (size_t)m * DM) + lane;
#pragma unroll
            for (int j = 0; j < 8; ++j) { u32x2 w; w.x = cvt_pk_bf16(v[j].x, v[j].y); w.y = cvt_pk_bf16(v[j].z, v[j].w); o[64 * j] = w; }
        }
    }
}

DI void ssm_phase(PP P, int l, unsigned char* lds, int G, int cid) {
    int tid = threadIdx.x; asm volatile("" : "+v"(tid));
    const int lane = tid & 63, wave = tid >> 6;
    float* E = (float*)lds;
    const bf16_t* ZU = (const bf16_t*)(P->ws + WS_Z);
    bf16_t* YG = (bf16_t*)(P->ws + WS_YG);
    for (int bg = cid; bg < NB * 64; bg += G) {
        const int b = bg >> 6, g = bg & 63, p = lane;
        const size_t gp = ((size_t)l * 64 + g) * 64 + p;
        const float lr = fminf(P->in[3][gp], -1e-4f), li = P->in[4][gp], dt = expf(P->in[5][l * 64 + g]);
        const float mag = expf(lr * dt), abr = mag * cosf(li * dt), abi = mag * sinf(li * dt);
        const float den = lr * lr + li * li, nr = abr - 1.f, ni = abi;
        const float fr = (nr * lr + ni * li) / den, fi = (ni * lr - nr * li) / den;
        float bbr[16], bbi[16], cr[16], ci[16];
#pragma unroll
        for (int c = 0; c < 16; ++c) {
            const float br = P->in[6][gp * 16 + c], bi = P->in[7][gp * 16 + c];
            bbr[c] = fr * br - fi * bi; bbi[c] = fr * bi + fi * br;
            cr[c] = P->in[8][(((size_t)l * 64 + g) * 16 + c) * 64 + p]; ci[c] = P->in[9][(((size_t)l * 64 + g) * 16 + c) * 64 + p];
        }
        const int cme = (lane >> 2) & 15;
        const float dme = P->in[10][(size_t)l * 1024 + g * 16 + cme];
        const int t0 = wave * 512;
        int vz = 0; asm volatile("" : "+v"(vz));
        const bf16_t* ub = ZU + ((size_t)b * SEQ + t0) * 1024 + g * 16 + vz;
        float sr = 0.f, si = 0.f;
        {
            u32x4 w0 = *(const u32x4*)ub, w1 = *(const u32x4*)(ub + 8);
            for (int t = 0; t < 512; ++t) {
                float u[16]; unpack8(w0, u); unpack8(w1, u + 8);
                const int tn = (t + 1 < 512) ? t + 1 : t;
                w0 = *(const u32x4*)(ub + (size_t)tn * 1024); w1 = *(const u32x4*)(ub + (size_t)tn * 1024 + 8);
                float bur = 0.f, bui = 0.f;
#pragma unroll
                for (int c = 0; c < 16; ++c) { bur += bbr[c] * u[c]; bui += bbi[c] * u[c]; }
                const float nsr = abr * sr - abi * si + bur, nsi = abr * si + abi * sr + bui;
                sr = nsr; si = nsi;
            }
        }
        __syncthreads();
        E[(wave * 64 + p) * 2] = sr; E[(wave * 64 + p) * 2 + 1] = si;
        float pr = abr, pi = abi;
#pragma unroll
        for (int i = 0; i < 9; ++i) { const float t = pr * pr - pi * pi; pi = 2.f * pr * pi; pr = t; }
        __syncthreads();
        sr = 0.f; si = 0.f;
        for (int w = 0; w < wave; ++w) { const float er = E[(w * 64 + p) * 2], ei = E[(w * 64 + p) * 2 + 1]; const float t = pr * sr - pi * si + er; si = pr * si + pi * sr + ei; sr = t; }
        {
            u32x4 w0 = *(const u32x4*)ub, w1 = *(const u32x4*)(ub + 8);
            for (int t = 0; t < 512; ++t) {
                float u[16]; unpack8(w0, u); unpack8(w1, u + 8);
                const int tn = (t + 1 < 512) ? t + 1 : t;
                w0 = *(const u32x4*)(ub + (size_t)tn * 1024); w1 = *(const u32x4*)(ub + (size_t)tn * 1024 + 8);
                float bur = 0.f, bui = 0.f;
#pragma unroll
                for (int c = 0; c < 16; ++c) { bur += bbr[c] * u[c]; bui += bbi[c] * u[c]; }
                const float nsr = abr * sr - abi * si + bur, nsi = abr * si + abi * sr + bui;
                sr = nsr; si = nsi;
                float w[16];
#pragma unroll
                for (int c = 0; c < 16; ++c) w[c] = cr[c] * sr - ci[c] * si;
                float w8[8], w4[4], w2[2], w1v;
                { const bool hi = lane & 32;
#pragma unroll
                  for (int j = 0; j < 8; ++j) { const float keep = hi ? w[8 + j] : w[j], send = hi ? w[j] : w[8 + j]; w8[j] = keep + __shfl_xor(send, 32); } }
                { const bool hi = lane & 16;
#pragma unroll
                  for (int j = 0; j < 4; ++j) { const float keep = hi ? w8[4 + j] : w8[j], send = hi ? w8[j] : w8[4 + j]; w4[j] = keep + __shfl_xor(send, 16); } }
                { const bool hi = lane & 8;
#pragma unroll
                  for (int j = 0; j < 2; ++j) { const float keep = hi ? w4[2 + j] : w4[j], send = hi ? w4[j] : w4[2 + j]; w2[j] = keep + __shfl_xor(send, 8); } }
                { const bool hi = lane & 4; const float keep = hi ? w2[1] : w2[0], send = hi ? w2[0] : w2[1]; w1v = keep + __shfl_xor(send, 4); }
                w1v += __shfl_xor(w1v, 2); w1v += __shfl_xor(w1v, 1);
                float ume = 0.f;
#pragma unroll
                for (int c = 0; c < 16; ++c) ume = (cme == c) ? u[c] : ume;
                const float y = w1v + dme * ume;
                const float gl = y * sigm(1.5957691216f * (y + 0.044715f * y * y * y));
                if ((lane & 3) == 0) YG[((size_t)b * SEQ + t0 + t) * 1024 + g * 16 + cme] = (bf16_t)(cvt_pk_bf16(gl, gl) & 0xffffu);
            }
        }
        __syncthreads();
    }
}


#define MFMA16(a, b, c) __builtin_amdgcn_mfma_f32_16x16x32_bf16((a), (b), (c), 0, 0, 0)
constexpr int SS_UL = 0, SS_SL = 33792, SS_EL = 33792 + 17408;
DI void ssm_mfma_phase(PP P, int l, unsigned char* lds, int G, int cid) {
    int tid = threadIdx.x; asm volatile("" : "+v"(tid));
    const int lane = tid & 63, wave = __builtin_amdgcn_readfirstlane(tid >> 6), n16 = lane & 15, q4 = lane >> 4;
    bf16_t* UL = (bf16_t*)(lds + SS_UL); bf16_t* SL = (bf16_t*)(lds + SS_SL); float* EL = (float*)(lds + SS_EL);
    const bf16_t* ZU = (const bf16_t*)(P->ws + WS_Z);
    bf16_t* YG = (bf16_t*)(P->ws + WS_YG);
    for (int bg = cid; bg < NB * 64; bg += G) {
        const int b = bg >> 6, g = bg & 63;
        const bf16_t* BP = (const bf16_t*)(P->ws + WS_SSMM + (size_t)g * SSM_GRP_BYTES); const bf16_t* KC = (const bf16_t*)(P->ws + WS_SSMM + (size_t)g * SSM_GRP_BYTES + SSM_KC_OFF);
        bf16x8 abp[8], akc[2][12];
#pragma unroll
        for (int ks = 0; ks < 8; ++ks) abp[ks] = *(const bf16x8*)(BP + (size_t)(wave * 16 + n16) * 256 + ks * 32 + q4 * 8);
#pragma unroll
        for (int rt = 0; rt < 2; ++rt)
#pragma unroll
            for (int ks = 0; ks < 12; ++ks) akc[rt][ks] = *(const bf16x8*)(KC + (size_t)((wave * 2 + rt) * 16 + n16) * 384 + ks * 32 + q4 * 8);
        float a16r = 1.f, a16i = 0.f, sr = 0.f, si = 0.f;
        if (wave == 0) {
            const int p = lane; const size_t gp = ((size_t)l * 64 + g) * 64 + p;
            const float lr = fminf(P->in[3][gp], -1e-4f), li = P->in[4][gp], dt = expf(P->in[5][l * 64 + g]);
            const float mag = expf(lr * dt); a16r = mag * cosf(li * dt); a16i = mag * sinf(li * dt);
#pragma unroll
            for (int i = 0; i < 4; ++i) { const float t = a16r * a16r - a16i * a16i; a16i = 2.f * a16r * a16i; a16r = t; }
        }
        for (int qt = 0; qt < 4; ++qt) {
            __syncthreads();
#pragma unroll
            for (int k = 0; k < 2; ++k) { const int t = tid + 512 * k;
                const bf16_t* up = ZU + ((size_t)b * SEQ + qt * 1024 + t) * 1024 + g * 16;
                const u32x4 w0 = *(const u32x4*)up, w1 = *(const u32x4*)(up + 8);
                bf16_t* dp = UL + (t >> 4) * 264 + (t & 15) * 16; *(u32x4*)dp = w0; *(u32x4*)(dp + 8) = w1; }
            __syncthreads();
#pragma unroll
            for (int jt = 0; jt < 4; ++jt) {
                f32x4 acc = {0.f, 0.f, 0.f, 0.f};
#pragma unroll
                for (int ks = 0; ks < 8; ++ks) { const bf16x8 bf = *(const bf16x8*)(UL + (jt * 16 + n16) * 264 + ks * 32 + q4 * 8); acc = MFMA16(abp[ks], bf, acc); }
                *(f32x4*)(EL + (jt * 16 + n16) * 128 + wave * 16 + 4 * q4) = acc;
            }
            __syncthreads();
            if (wave == 0) {
#pragma unroll 1
                for (int jb = 0; jb < 64; jb += 16) {
                    float er[16], ei[16];
#pragma unroll
                    for (int k = 0; k < 16; ++k) { er[k] = EL[(jb + k) * 128 + lane]; ei[k] = EL[(jb + k) * 128 + 64 + lane]; }
#pragma unroll
                    for (int k = 0; k < 16; ++k) {
                        SL[(jb + k) * 136 + lane] = (bf16_t)(cvt_pk_bf16(sr, sr) & 0xffffu); SL[(jb + k) * 136 + 64 + lane] = (bf16_t)(cvt_pk_bf16(si, si) & 0xffffu);
                        const float t = a16r * sr - a16i * si + er[k]; si = a16r * si + a16i * sr + ei[k]; sr = t;
                    }
                }
            }
            __syncthreads();
#pragma unroll
            for (int rt = 0; rt < 2; ++rt)
#pragma unroll
                for (int jt = 0; jt < 4; ++jt) {
                    f32x4 acc = {0.f, 0.f, 0.f, 0.f};
#pragma unroll
                    for (int ks = 0; ks < 8; ++ks) { const bf16x8 bf = *(const bf16x8*)(UL + (jt * 16 + n16) * 264 + ks * 32 + q4 * 8); acc = MFMA16(akc[rt][ks], bf, acc); }
#pragma unroll
                    for (int ks = 0; ks < 4; ++ks) { const bf16x8 bf = *(const bf16x8*)(SL + (jt * 16 + n16) * 136 + ks * 32 + q4 * 8); acc = MFMA16(akc[rt][8 + ks], bf, acc); }
                    float o[4];
#pragma unroll
                    for (int k = 0; k < 4; ++k) { const float y = acc[k]; o[k] = y * sigm(1.5957691216f * (y + 0.044715f * y * y * y)); }
                    u32x2 w; w.x = cvt_pk_bf16(o[0], o[1]); w.y = cvt_pk_bf16(o[2], o[3]);
                    const int t = qt * 1024 + (jt * 16 + n16) * 16 + (wave * 2 + rt);
                    *(u32x2*)(YG + ((size_t)b * SEQ + t) * 1024 + g * 16 + 4 * q4) = w;
                }
        }
    }
    __syncthreads();
}

DI int t5_bucket(int rel) {
    const int ret = rel > 0 ? 16 : 0; const int n = rel < 0 ? -rel : rel;
    int v;
    if (n < 8) v = n;
    else { const float f = logf((float)n / 8.f) / logf(16.f) * 8.f; int lg = 8 + (int)(f + 1e-4f); v = lg < 15 ? lg : 15; }
    return ret + v;
}
DI void attn_phase(PP P, int l, unsigned char* lds, int G, int cid) {
    int tid = threadIdx.x; asm volatile("" : "+v"(tid));
    const int lane = tid & 63;
    float* Ks = (float*)lds;
    float* Vs = Ks + 64 * 128;
    float* tb = Vs + 64 * 128;
    float* red = tb + 192;
    float* Ox = Ks;
    const bf16_t* Zq = (const bf16_t*)(P->ws + WS_Z) + 1 * ZBLK; const bf16_t* Zk = Zq + ZBLK; const bf16_t* Zv = Zk + ZBLK;
    bf16_t* YY = (bf16_t*)(P->ws + WS_YY);
    const float* qw = P->in[13] + l * 64; const float* kw = P->in[14] + l * 64;
    const float linit = (l == 0) ? 0.2f : 0.35550906759096926f;
    float d1 = 0.f, d2 = 0.f, mq = 0.f, mk = 0.f;
    for (int i = 0; i < 64; ++i) { d1 += P->in[15][l * 64 + i] * P->in[16][l * 64 + i]; d2 += P->in[17][l * 64 + i] * P->in[18][l * 64 + i]; mq = fmaxf(mq, fabsf(qw[i])); mk = fmaxf(mk, fabsf(kw[i])); }
    const float lam = expf(d1) - expf(d2) + linit;
    const int row = tid & 63, map = (tid >> 6) & 1, eq = tid >> 7;
    for (int u = cid; u < 2048; u += G) {
        const int w = u & 255, i = u >> 8, bh = w >> 3, r = w & 7, b = bh >> 3, h = bh & 7;
        const int c = (i >> 1) * 16 + ((i & 1) ? 15 - r : r);
        float mb = 0.f;
        for (int k = 0; k < 32; ++k) mb = fmaxf(mb, fabsf(P->in[23][k * 8 + h]));
        const float smax = 8.f * mq * mk + mb;
        __syncthreads();
        if (tid < 192) tb[tid] = P->in[23][t5_bucket(tid - 128) * 8 + h];
        float q[64];
        {
            const bf16_t* qp = Zq + ((size_t)b * SEQ + c * 64 + row) * 1024 + h * 128 + map * 64;
            float ss = 0.f;
#pragma unroll
            for (int j = 0; j < 8; ++j) { unpack8(*(const u32x4*)(qp + 8 * j), q + 8 * j); }
#pragma unroll
            for (int d = 0; d < 64; ++d) ss += q[d] * q[d];
            const float rs = rsqrtf(ss * (1.f / 64.f) + 1e-6f) * 0.125f;
#pragma unroll
            for (int d = 0; d < 64; ++d) q[d] = q[d] * rs * qw[d];
        }
        float o[32], lsum = 0.f;
#pragma unroll
        for (int e = 0; e < 32; ++e) o[e] = 0.f;
        for (int kt = 0; kt <= c; ++kt) {
            __syncthreads();
            {
                const int pair = tid >> 2, key = pair >> 1, mp = pair & 1, d0 = (tid & 3) * 16;
                const bf16_t* kp = Zk + ((size_t)b * SEQ + kt * 64 + key) * 1024 + h * 128 + mp * 64 + d0;
                float kv[16]; unpack8(*(const u32x4*)kp, kv); unpack8(*(const u32x4*)(kp + 8), kv + 8);
                float ss = 0.f;
#pragma unroll
                for (int d = 0; d < 16; ++d) ss += kv[d] * kv[d];
                ss += __shfl_xor(ss, 1); ss += __shfl_xor(ss, 2);
                const float rs = rsqrtf(ss * (1.f / 64.f) + 1e-6f);
#pragma unroll
                for (int d = 0; d < 16; ++d) Ks[key * 128 + mp * 64 + d0 + d] = kv[d] * rs * kw[d0 + d];
                const int vkey = tid >> 3, e0 = (tid & 7) * 16;
                const bf16_t* vp = Zv + ((size_t)b * SEQ + kt * 64 + vkey) * 1024 + h * 128 + e0;
                float vv[16]; unpack8(*(const u32x4*)vp, vv); unpack8(*(const u32x4*)(vp + 8), vv + 8);
#pragma unroll
                for (int d = 0; d < 16; ++d) Vs[vkey * 128 + e0 + d] = vv[d];
            }
            __syncthreads();
            for (int j = 0; j < 64; ++j) {
                const f32x4* kr = (const f32x4*)(Ks + j * 128 + map * 64);
                float s = 0.f;
#pragma unroll
                for (int d4 = 0; d4 < 16; ++d4) { const f32x4 kk = kr[d4]; s += q[4 * d4] * kk.x + q[4 * d4 + 1] * kk.y + q[4 * d4 + 2] * kk.z + q[4 * d4 + 3] * kk.w; }
                int rel = (kt - c) * 64 + j - row; rel = rel < -128 ? -128 : rel;
                s += tb[rel + 128];
                const float pexp = __expf(s - smax);
                lsum += pexp;
                const f32x4* vr = (const f32x4*)(Vs + j * 128 + eq * 32);
#pragma unroll
                for (int e4 = 0; e4 < 8; ++e4) { const f32x4 vv = vr[e4]; o[4 * e4] += pexp * vv.x; o[4 * e4 + 1] += pexp * vv.y; o[4 * e4 + 2] += pexp * vv.z; o[4 * e4 + 3] += pexp * vv.w; }
            }
        }
        __syncthreads();
        {
            const float inv = 1.f / lsum;
#pragma unroll
            for (int e = 0; e < 32; ++e) Ox[(map * 64 + row) * 129 + eq * 32 + e] = o[e] * inv;
        }
        __syncthreads();
        {
            const int part = tid >> 6, e0 = part * 16;
            float val[16], ssq = 0.f;
#pragma unroll
            for (int e = 0; e < 16; ++e) { val[e] = Ox[row * 129 + e0 + e] - lam * Ox[(64 + row) * 129 + e0 + e]; ssq += val[e] * val[e]; }
            red[row * 8 + part] = ssq;
            __syncthreads();
            float tot = 0.f;
#pragma unroll
            for (int k = 0; k < 8; ++k) tot += red[row * 8 + k];
            const float rs = rsqrtf(tot * (1.f / 128.f) + 1e-5f) * (1.f - linit);
            const float* sw = P->in[19] + l * 128 + e0;
            bf16_t* op = YY + ((size_t)b * SEQ + c * 64 + row) * 2048 + 1024 + h * 128 + e0;
            u32x4 w0, w1;
            w0.x = cvt_pk_bf16(val[0] * rs * sw[0], val[1] * rs * sw[1]); w0.y = cvt_pk_bf16(val[2] * rs * sw[2], val[3] * rs * sw[3]);
            w0.z = cvt_pk_bf16(val[4] * rs * sw[4], val[5] * rs * sw[5]); w0.w = cvt_pk_bf16(val[6] * rs * sw[6], val[7] * rs * sw[7]);
            w1.x = cvt_pk_bf16(val[8] * rs * sw[8], val[9] * rs * sw[9]); w1.y = cvt_pk_bf16(val[10] * rs * sw[10], val[11] * rs * sw[11]);
            w1.z = cvt_pk_bf16(val[12] * rs * sw[12], val[13] * rs * sw[13]); w1.w = cvt_pk_bf16(val[14] * rs * sw[14], val[15] * rs * sw[15]);
            *(u32x4*)op = w0; *(u32x4*)(op + 8) = w1;
        }
    }
    __syncthreads();
}


constexpr float LOG2E = 1.4426950408889634f;
DI void prep_phase(PP P, int l, unsigned char* lds, int G, int cid) {
    int tid = threadIdx.x; asm volatile("" : "+v"(tid));
    const int lane = tid & 63, wave = tid >> 6;
    const int gw = cid * 8 + wave, NGW = G * 8;
    const bf16_t* Zv = (const bf16_t*)(P->ws + WS_Z) + 3 * ZBLK;
    bf16_t* VT = (bf16_t*)(P->ws + WS_VT);
    bf16_t* tile = (bf16_t*)(lds + wave * 18432);
    for (int it = gw; it < 2048; it += NGW) {
        const int bh = it >> 6, tt = it & 63, b = bh >> 3, h = bh & 7;
#pragma unroll
        for (int i = 0; i < 16; ++i) { const int t = 4 * i + (lane >> 4), ch = lane & 15;
            const u32x4 w = *(const u32x4*)(Zv + ((size_t)b * SEQ + tt * 64 + t) * 1024 + h * 128 + ch * 8);
            *(u32x4*)(tile + t * 136 + ch * 8) = w; }
        LDS_WAIT();
#pragma unroll 2
        for (int ps = 0; ps < 16; ++ps) { const int e = ps * 8 + (lane >> 3), c8 = lane & 7;
            const bf16_t* tp = tile + (c8 * 8) * 136 + e;
            u32x4 w;
            w.x = (unsigned)tp[0] | ((unsigned)tp[136] << 16); w.y = (unsigned)tp[2 * 136] | ((unsigned)tp[3 * 136] << 16);
            w.z = (unsigned)tp[4 * 136] | ((unsigned)tp[5 * 136] << 16); w.w = (unsigned)tp[6 * 136] | ((unsigned)tp[7 * 136] << 16);
            *(u32x4*)(VT + ((size_t)bh * 128 + e) * SEQ + tt * 64 + c8 * 8) = w; }
        LDS_WAIT();
    }
}

typedef float f32x16 __attribute__((ext_vector_type(16)));
typedef float f32x2v __attribute__((ext_vector_type(2)));
typedef __bf16 bf16x2v __attribute__((ext_vector_type(2)));
DI unsigned pk_bf16(float lo, float hi) { f32x2v v = {lo, hi}; bf16x2v b = __builtin_convertvector(v, bf16x2v); return __builtin_bit_cast(unsigned, b); }
DI bf16x8 pack8(const f32x16& x, int s) {
    u32x4 p; p.x = pk_bf16(x[8 * s], x[8 * s + 1]); p.y = pk_bf16(x[8 * s + 2], x[8 * s + 3]); p.z = pk_bf16(x[8 * s + 4], x[8 * s + 5]); p.w = pk_bf16(x[8 * s + 6], x[8 * s + 7]);
    return __builtin_bit_cast(bf16x8, p);
}
#define MFMA32(a, b, c) __builtin_amdgcn_mfma_f32_32x32x16_bf16((a), (b), (c), 0, 0, 0)
constexpr int AT_KS = 16384, AT_V0 = 32768, AT_TB = 65536;
typedef __attribute__((address_space(3))) unsigned char* ldsp_t;
template <bool NEAR>
DI void attn_qk(f32x16& s0, f32x16& s1, ldsp_t kb, const int* kro, const bf16x8* qf, int dtile, const float* tb2, int hi, int qg, int r32) {
    bf16x8 a[8];
#pragma unroll
    for (int ks = 0; ks < 4; ++ks) { a[2 * ks] = *(const __attribute__((address_space(3))) bf16x8*)(kb + kro[ks]); a[2 * ks + 1] = *(const __attribute__((address_space(3))) bf16x8*)(kb + kro[ks] + 8192); }
    if (!NEAR) {
        const float c0 = tb2[0];
#pragma unroll
        for (int k = 0; k < 16; ++k) { s0[k] = c0; s1[k] = c0; }
    } else {
        const int base = dtile * 64 + 8 * hi - (qg & 1) * 32 - r32 + 128;
#pragma unroll
        for (int k = 0; k < 16; ++k) { const int i0 = base + (k & 7) + 16 * (k >> 3), i1 = i0 + 32; s0[k] = tb2[i0 < 0 ? 0 : i0]; s1[k] = tb2[i1 < 0 ? 0 : i1]; }
    }
#pragma unroll
    for (int ks = 0; ks < 4; ++ks) { s0 = MFMA32(a[2 * ks], qf[ks], s0); s1 = MFMA32(a[2 * ks + 1], qf[ks], s1); }
}
DI void attn_pv(f32x16& s0, f32x16& s1, ldsp_t vb, const int* vro, f32x16* o, float& lsum) {
#pragma unroll
    for (int k = 0; k < 16; ++k) { s0[k] = __builtin_amdgcn_exp2f(s0[k]); s1[k] = __builtin_amdgcn_exp2f(s1[k]); }
    float ps = 0.f;
#pragma unroll
    for (int k = 0; k < 16; ++k) ps += s0[k] + s1[k];
    lsum += ps;
    bf16x8 pk[4]; pk[0] = pack8(s0, 0); pk[1] = pack8(s0, 1); pk[2] = pack8(s1, 0); pk[3] = pack8(s1, 1);
#pragma unroll
    for (int kk = 0; kk < 4; ++kk)
#pragma unroll
        for (int et = 0; et < 4; ++et) {
            const bf16x8 a = *(const __attribute__((address_space(3))) bf16x8*)(vb + vro[kk] + et * 4096);
            o[et] = MFMA32(a, pk[kk], o[et]);
        }
}
#define AT_DMA(gp, dst) __builtin_amdgcn_global_load_lds((const unsigned*)(gp), (__attribute__((address_space(3))) unsigned*)(dst), 16, 0, 0)
DI void attn_mfma_phase(PP P, int l, unsigned char* lds, int G, int cid) {
    int tid = threadIdx.x; asm volatile("" : "+v"(tid));
    const int lane = tid & 63, wave = __builtin_amdgcn_readfirstlane(tid >> 6), r32 = lane & 31, hi = lane >> 5, qg = wave & 3, map = wave >> 2;
    ldsp_t ldsl = (ldsp_t)lds;
    float* tb2 = (float*)(lds + AT_TB);
    float* OX = (float*)lds;
    const bf16_t* Zq = (const bf16_t*)(P->ws + WS_Z) + ZBLK; const bf16_t* Zk = Zq + ZBLK;
    const bf16_t* VT = (const bf16_t*)(P->ws + WS_VT);
    bf16_t* YY = (bf16_t*)(P->ws + WS_YY);
    const float linit = (l == 0) ? 0.2f : 0.35550906759096926f;
    float d1 = 0.f, d2 = 0.f, mq = 0.f, mk = 0.f;
    for (int i = 0; i < 64; ++i) { d1 += P->in[15][l * 64 + i] * P->in[16][l * 64 + i]; d2 += P->in[17][l * 64 + i] * P->in[18][l * 64 + i];
        mq = fmaxf(mq, fabsf(P->in[13][l * 64 + i])); mk = fmaxf(mk, fabsf(P->in[14][l * 64 + i])); }
    const float lam = expf(d1) - expf(d2) + linit;
    const int pir = (r32 & ~12) | ((r32 & 4) << 1) | ((r32 & 8) >> 1);
    int kro[4], vro[4];
#pragma unroll
    for (int k = 0; k < 4; ++k) { kro[k] = pir * 256 + (((map * 8 + k * 2 + hi) ^ (pir & 15)) * 16); vro[k] = AT_V0 + r32 * 128 + (((k * 2 + hi) ^ ((r32 >> 1) & 7)) * 16); }
    for (int u = cid; u < 1024; u += G) {
        const int w = u & 255, i = u >> 8, bh = w >> 3, r = w & 7, b = bh >> 3, h = bh & 7;
        const int j = (i >> 1) * 16 + ((i & 1) ? 15 - r : r);
        const int mychunk = 2 * j + (qg >> 1), qpos = j * 128 + qg * 32 + r32;
        float mb = 0.f;
        for (int k = 0; k < 32; ++k) mb = fmaxf(mb, fabsf(P->in[23][k * 8 + h]));
        const float smax2 = (8.f * mq * mk + mb) * LOG2E;
        __syncthreads();
        if (tid < 192) tb2[tid] = P->in[23][t5_bucket(tid - 128) * 8 + h] * LOG2E - smax2;
        bf16x8 qf[4];
        { const bf16_t* qp = Zq + ((size_t)b * SEQ + qpos) * 1024 + h * 128 + map * 64 + 8 * hi;
#pragma unroll
          for (int ks = 0; ks < 4; ++ks) qf[ks] = *(const bf16x8*)(qp + ks * 16); }
        f32x16 o[4];
#pragma unroll
        for (int et = 0; et < 4; ++et)
#pragma unroll
            for (int k = 0; k < 16; ++k) o[et][k] = 0.f;
        float lsum = 0.f;
        const bf16_t* kg[2]; const bf16_t* vg[2];
#pragma unroll
        for (int i2 = 0; i2 < 2; ++i2) { const int blk = wave * 2 + i2;
            { const int row = blk * 4 + (lane >> 4), c = (lane & 15) ^ (row & 15); kg[i2] = Zk + ((size_t)b * SEQ + row) * 1024 + h * 128 + c * 8; }
            { const int row = blk * 8 + (lane >> 3), c = (lane & 7) ^ ((row >> 1) & 7); vg[i2] = VT + ((size_t)bh * 128 + row) * SEQ + c * 8; } }
        const int dw = wave * 2048;
#define AT_LOADK(t) do { AT_DMA(kg[0] + (size_t)(t) * 65536, ldsl + ((t) & 1) * AT_KS + dw); AT_DMA(kg[1] + (size_t)(t) * 65536, ldsl + ((t) & 1) * AT_KS + dw + 1024); } while (0)
#define AT_LOADV(t) do { AT_DMA(vg[0] + (t) * 64, ldsl + AT_V0 + ((t) & 1) * AT_KS + dw); AT_DMA(vg[1] + (t) * 64, ldsl + AT_V0 + ((t) & 1) * AT_KS + dw + 1024); } while (0)
        AT_LOADK(0); AT_LOADV(0); AT_LOADK(1);
        __syncthreads();
        f32x16 sc0, sc1, sn0, sn1;
        attn_qk<true>(sc0, sc1, ldsl, kro, qf, 0 - mychunk, tb2, hi, qg, r32);
        const int nfar = 2 * j - 3;
        int kt = 0;
        for (; kt < nfar; ++kt) {
            AT_LOADK(kt + 2); AT_LOADV(kt + 1);
            attn_qk<false>(sn0, sn1, ldsl + ((kt + 1) & 1) * AT_KS, kro, qf, 0, tb2, hi, qg, r32);
            attn_pv(sc0, sc1, ldsl + (kt & 1) * AT_KS, vro, o, lsum);
            sc0 = sn0; sc1 = sn1;
            __syncthreads();
        }
        for (; kt < 2 * j; ++kt) {
            AT_LOADK(kt + 2); AT_LOADV(kt + 1);
            attn_qk<true>(sn0, sn1, ldsl + ((kt + 1) & 1) * AT_KS, kro, qf, kt + 1 - mychunk, tb2, hi, qg, r32);
            attn_pv(sc0, sc1, ldsl + (kt & 1) * AT_KS, vro, o, lsum);
            sc0 = sn0; sc1 = sn1;
            __syncthreads();
        }
        AT_LOADV(2 * j + 1);
        if (qg >= 2) attn_qk<true>(sn0, sn1, ldsl + AT_KS, kro, qf, 0, tb2, hi, qg, r32);
        attn_pv(sc0, sc1, ldsl, vro, o, lsum);
        __syncthreads();
        if (qg >= 2) attn_pv(sn0, sn1, ldsl + AT_KS, vro, o, lsum);
        __syncthreads();
        lsum += __shfl_xor(lsum, 32);
        const float inv = 1.f / lsum;
        if (map == 1) {
#pragma unroll
            for (int et = 0; et < 4; ++et)
#pragma unroll
                for (int k = 0; k < 16; ++k) OX[(qg * 64 + et * 16 + k) * 64 + lane] = o[et][k] * inv;
        }
        __syncthreads();
        if (map == 0) {
            float ssq = 0.f;
#pragma unroll
            for (int et = 0; et < 4; ++et)
#pragma unroll
                for (int k = 0; k < 16; ++k) { const float v = o[et][k] * inv - lam * OX[(qg * 64 + et * 16 + k) * 64 + lane]; o[et][k] = v; ssq += v * v; }
            ssq += __shfl_xor(ssq, 32);
            const float rs = rsqrtf(ssq * (1.f / 128.f) + 1e-5f) * (1.f - linit);
            bf16_t* op = YY + ((size_t)b * SEQ + qpos) * 2048 + 1024 + h * 128 + 4 * hi;
            const float* sw = P->in[19] + l * 128 + 4 * hi;
#pragma unroll
            for (int et = 0; et < 4; ++et)
#pragma unroll
                for (int g4 = 0; g4 < 4; ++g4) {
                    const f32x4 wv = *(const f32x4*)(sw + et * 32 + 8 * g4);
                    u32x2 wo; wo.x = pk_bf16(o[et][4 * g4] * rs * wv.x, o[et][4 * g4 + 1] * rs * wv.y); wo.y = pk_bf16(o[et][4 * g4 + 2] * rs * wv.z, o[et][4 * g4 + 3] * rs * wv.w);
                    *(u32x2*)(op + et * 32 + 8 * g4) = wo;
                }
        }
    }
    __syncthreads();
}


#define XB_TMO      128
#define XB_XCNT(j)  (256  + 64 * (j))
#define XB_XSUB(j)  (1280 + 64 * (j))
#define XB_XGEN(j)  (2304 + 64 * (j))
#define XB_TOP      3328
#define XB_TOPGEN   3392
#define XCD_BAR_WORDS 3456
#define XB_SPIN_CAP (1u << 18)

__device__ __forceinline__ unsigned xb_ld(unsigned* p)              { return __hip_atomic_load(p, __ATOMIC_RELAXED, __HIP_MEMORY_SCOPE_AGENT); }
__device__ __forceinline__ unsigned xb_add(unsigned* p, unsigned v) { return __hip_atomic_fetch_add(p, v, __ATOMIC_RELAXED, __HIP_MEMORY_SCOPE_AGENT); }
__device__ __forceinline__ unsigned xb_xcc_id() { return (unsigned)__builtin_amdgcn_s_getreg((3 << 11) | 20) & 0xFu; }
#define XB_SPIN(cond, bar) do { unsigned _sp = 0; while (cond) { __builtin_amdgcn_s_sleep(1); \
    if ((++_sp & 255u) == 0u) { if (xb_ld(&(bar)[XB_TMO])) break; if (_sp > XB_SPIN_CAP) { atomicAdd(&(bar)[XB_TMO], 1u); break; } } } } while (0)

struct XcdBarrier {
    unsigned* bar; unsigned x;
    volatile LAS unsigned* st;
};

__device__ __forceinline__ XcdBarrier xcd_barrier_post(unsigned* bar, volatile LAS unsigned* st) {
    XcdBarrier b; b.bar = bar; b.x = xb_xcc_id(); b.st = st;
    if (threadIdx.x == 0) (void)xb_add(&bar[XB_XCNT(b.x)], 1u);
    return b;
}
__device__ __forceinline__ void xcd_barrier_complete(unsigned* bar, unsigned x, unsigned& nloc, unsigned& nx) {
    const unsigned G = gridDim.x * gridDim.y * gridDim.z;
    unsigned sum, cnt, mine, sp = 0u;
    for (;;) {
        sum = 0u; cnt = 0u; mine = 0u;
#pragma unroll
        for (unsigned j = 0; j < 16; ++j) { const unsigned c = xb_ld(&bar[XB_XCNT(j)]); sum += c; cnt += (c > 0u) ? 1u : 0u; mine = (j == x) ? c : mine; }
        if (sum == G) break;
        __builtin_amdgcn_s_sleep(1);
        if ((++sp & 255u) == 0u) { if (xb_ld(&bar[XB_TMO])) break; if (sp > XB_SPIN_CAP) { atomicAdd(&bar[XB_TMO], 1u); break; } }
    }
    nloc = mine > 0u ? mine : 1u; nx = cnt > 0u ? cnt : 1u;
}

__device__ __forceinline__ void xcd_barrier(const XcdBarrier& b) {
    asm volatile("s_waitcnt vmcnt(0)" ::: "memory");
    __syncthreads();
    if (threadIdx.x == 0) {
        unsigned* bar = b.bar;
        __builtin_amdgcn_s_waitcnt(0);
        unsigned nloc = b.st[0], nx = b.st[1];
        if (nloc == 0u) { xcd_barrier_complete(bar, b.x, nloc, nx); b.st[0] = nloc; b.st[1] = nx; }
        const unsigned old = xb_add(&bar[XB_XSUB(b.x)], 1u);
        const unsigned gen = old / nloc;
        if (old + 1u == (gen + 1u) * nloc) {
            __builtin_amdgcn_fence(__ATOMIC_RELEASE, "agent");
            asm volatile("s_waitcnt vmcnt(0)" ::: "memory");
            const unsigned og = xb_add(&bar[XB_TOP], 1u);
            const unsigned tg = og / nx;
            if (og + 1u == (tg + 1u) * nx) xb_add(&bar[XB_TOPGEN], 1u);
            else XB_SPIN(xb_ld(&bar[XB_TOPGEN]) == tg, bar);
            __builtin_amdgcn_fence(__ATOMIC_ACQUIRE, "agent");
            xb_add(&bar[XB_XGEN(b.x)], 1u);
            asm volatile("s_waitcnt vmcnt(0)" ::: "memory");
        } else {
            XB_SPIN(xb_ld(&bar[XB_XGEN(b.x)]) == gen, bar);
            __builtin_amdgcn_fence(__ATOMIC_ACQUIRE, "agent");
            asm volatile("s_waitcnt vmcnt(0)" ::: "memory");
        }
    }
    __syncthreads();
}


#ifndef PHMASK
#define PHMASK 127
#endif
constexpr int PH_PER_LAYER = 8, N_PHASES = 16;
__global__ void __launch_bounds__(512, 2) mega_fwd(Params Pin) {
    extern __shared__ __attribute__((aligned(16))) unsigned char lds[];
    cg::grid_group grid = cg::this_grid();
    PG8_LAS unsigned char* ldsl = (PG8_LAS unsigned char*)lds;
    const int ph_lo = Pin.ph_lo, ph_hi = Pin.ph_hi;
    volatile LAS unsigned* misc = (volatile LAS unsigned*)((LAS unsigned char*)lds + LDS_MISC);
    if (threadIdx.x < 16) misc[threadIdx.x] = 0u;
    __syncthreads();
    XcdBarrier xbar = xcd_barrier_post((unsigned*)(Pin.ws + WS_CTL), misc);
    for (int ph = ph_lo; ph < ph_hi; ++ph) {
        const int l = ph >> 3, q = ph & 7;
        PP P = (PP)__builtin_amdgcn_kernarg_segment_ptr(); asm volatile("" : "+s"(P));
        unsigned char* ws = P->ws;
        int G = gridDim.x, cid = blockIdx.x; asm volatile("" : "+s"(G), "+s"(cid));
        u64* rowss = (u64*)(ws + WS_ROWSS);
        bf16_t* Z = (bf16_t*)(ws + WS_Z);
        bf16_t* XB = (bf16_t*)(ws + WS_XB);
        bf16_t* YY = (bf16_t*)(ws + WS_YY);
        bf16_t* MB = (bf16_t*)(ws + WS_MB);
        if (q == 0 && (PHMASK & 1)) {
            conv_phase(P, l, lds, G, cid);
        } else if (q == 1 && (PHMASK & 2)) {
            pg8::Gemm g{XB, (const bf16_t*)(ws + WS_WIN), MTOK, NIN, DM, DM, DM}; pg8::StaticOrder S; S.init(MTOK, NIN, G, cid);
            EpiIn E{Z, rowss + (size_t)(2 * l) * MTOK, (float*)(lds + 131072), P->in[13] + l * 64, P->in[14] + l * 64};
            pg8::gemm_phase(ldsl, g, S, E);
        } else if (q == 2 && (PHMASK & 4)) {
#ifdef NAIVE_SSM
            ssm_phase(P, l, lds, G, cid);
#else
            ssm_mfma_phase(P, l, lds, G, cid);
#endif
#ifdef NAIVE_ATTN
            attn_phase(P, l, lds, G, cid);
#else
            prep_phase(P, l, lds, G, cid);
#endif
        } else if (q == 3 && (PHMASK & 8)) {
            pg8::Gemm g{(const bf16_t*)(ws + WS_YG), (const bf16_t*)(ws + WS_WGLU), MTOK, 1024, 1024, 1024, 1024}; pg8::StaticOrder S; S.init(MTOK, 1024, G, cid);
            EpiGlu E{(const bf16_t*)(ws + WS_YG), P->in[12] + l * 1024, YY};
            pg8::gemm_phase(ldsl, g, S, E);
#ifndef NAIVE_ATTN
            attn_mfma_phase(P, l, lds, G, cid);
#endif
        } else if (q == 4 && (PHMASK & 16)) {
            for (int half = 0; half < 2; ++half) {
                pg8::Gemm g{YY + half * 1024, (const bf16_t*)(ws + WS_WM) + half * 1024, MTOK, DM, 1024, 2048, 2048}; pg8::StaticOrder S; S.init(MTOK, DM, G, cid);
                EpiMerge E{Z + (size_t)(4 + 2 * half) * ZBLK, MB, half};
                pg8::gemm_phase(ldsl, g, S, E);
                __syncthreads();
            }
        } else if ((q == 5 || q == 7) && (PHMASK & 32)) {
            const bool dn = (q == 7);
            pg8::Gemm g{dn ? (const bf16_t*)(ws + WS_ACT) : MB, (const bf16_t*)(ws + (dn ? WS_WDN : WS_WOUT)), MTOK, DM, dn ? DFF : DM, dn ? DFF : DM, dn ? DFF : DM};
            pg8::StaticOrder S; S.init(MTOK, DM, G, cid);
            const float* xold = (l == 0 && !dn) ? P->in[0] : P->out;
            const int emit = !(dn && l == 1);
            EpiRes E{xold, P->out, XB, rowss + (size_t)(2 * l + (dn ? 2 : 1)) * MTOK, emit};
            pg8::gemm_phase(ldsl, g, S, E);
        } else if (q == 6 && (PHMASK & 64)) {
            pg8::Gemm g{XB, (const bf16_t*)(ws + WS_WGU), MTOK, NGU, DM, DM, DM}; pg8::StaticOrder S; S.init(MTOK, NGU, G, cid);
            EpiUp E{rowss + (size_t)(2 * l + 1) * MTOK, (bf16_t*)(ws + WS_ACT)};
            pg8::gemm_phase(ldsl, g, S, E);
        }
        if (ph + 1 < ph_hi) { if (ph == ph_lo) grid.sync(); else xcd_barrier(xbar); }
    }
}

#ifndef MK_COOP
#define MK_COOP 1
#endif
extern "C" void kernel_launch(void* const* d_in, const int* in_sizes, int n_in, void* d_out, int out_size, void* d_ws, size_t ws_size, hipStream_t stream) {
    static int grid = 0;
    if (grid == 0) {
        if (n_in != 28 || out_size != MTOK * DM || ws_size < WS_END) { fprintf(stderr, "kernel_launch: unexpected shapes (n_in %d out %d ws %zu)\n", n_in, out_size, ws_size); grid = -1; return; }
        int dev = 0, cus = 0, per_cu = 0;
        hipGetDevice(&dev);
        hipDeviceGetAttribute(&cus, hipDeviceAttributeMultiprocessorCount, dev);
        hipFuncSetAttribute((const void*)mega_fwd, hipFuncAttributeMaxDynamicSharedMemorySize, LDS_BYTES);
        hipOccupancyMaxActiveBlocksPerMultiprocessor(&per_cu, (const void*)mega_fwd, 512, LDS_BYTES);
        if (per_cu < 1) { fprintf(stderr, "kernel_launch: occupancy query says %d blocks per CU\n", per_cu); per_cu = 1; }
        (void)hipGetLastError();
        grid = cus * 1;
    }
    if (grid < 0) return;
    if (hipMemsetAsync((char*)d_ws + WS_CTL, 0, CTL_BYTES, stream) != hipSuccess) { fprintf(stderr, "kernel_launch: memset of the barrier words failed\n"); return; }
    Params p{};
    for (int i = 0; i < 28; ++i) p.in[i] = (const float*)d_in[i];
    p.out = (float*)d_out; p.ws = (unsigned char*)d_ws;
#if MK_COOP
    p.ph_lo = 0; p.ph_hi = N_PHASES;
    void* args[] = {&p};
    hipError_t e = hipLaunchCooperativeKernel((const void*)mega_fwd, dim3(grid), dim3(512), args, LDS_BYTES, stream);
    if (e != hipSuccess) fprintf(stderr, "cooperative launch failed: %s (grid %d)\n", hipGetErrorString(e), grid);
#else
    for (int ph = 0; ph < N_PHASES; ++ph) {
        p.ph_lo = ph; p.ph_hi = ph + 1;
        hipLaunchKernelGGL(mega_fwd, dim3(grid), dim3(512), LDS_BYTES, stream, p);
    }
#endif
}
```

```cpp
#include <hip/hip_runtime.h>
#include <hip/hip_cooperative_groups.h>
#include <cstdio>
#include <cstdint>
namespace cg = cooperative_groups;

typedef unsigned short bf16_t;
typedef short bf16x8 __attribute__((ext_vector_type(8)));
typedef float f32x4 __attribute__((ext_vector_type(4)));
typedef unsigned u32x4 __attribute__((ext_vector_type(4)));
typedef unsigned u32x2 __attribute__((ext_vector_type(2)));
#define LAS __attribute__((address_space(3)))
#define DI __device__ __forceinline__

constexpr int NB = 4, SEQ = 4096, MTOK = NB * SEQ, DM = 2048, NIN = 8192, DFF = 5632, NGU = 2 * DFF;
constexpr size_t MiB = 1u << 20;
constexpr size_t WS_WIN = 0, WS_WGLU = 32 * MiB, WS_WM = 34 * MiB, WS_WOUT = 42 * MiB, WS_WGU = 50 * MiB, WS_WDN = 94 * MiB;
constexpr size_t WS_XB = 116 * MiB;
constexpr size_t WS_Z = 180 * MiB;
constexpr size_t ZBLK = (size_t)MTOK * 1024;
constexpr size_t WS_MB = 212 * MiB;
constexpr size_t WS_ACT = 180 * MiB;
constexpr size_t WS_YG = 436 * MiB;
constexpr size_t WS_YY = 468 * MiB;
constexpr size_t WS_VT = 532 * MiB;
constexpr size_t WS_SSMM = 564 * MiB;
constexpr size_t WS_ROWSS = 580 * MiB;
constexpr size_t WS_CTL = 581 * MiB, CTL_BYTES = 16384;
constexpr size_t WS_END = 582 * MiB;
constexpr int LDS_BYTES = 147456, LDS_MISC = 147392;

struct Params {
    const float* in[28];
    float* out;
    unsigned char* ws;
    int ph_lo, ph_hi;
};

typedef const __attribute__((address_space(4))) Params* PP;
typedef unsigned u64;
constexpr float RS_SCALE = 4096.f, RS_INV = 1.f / 4096.f;
DI unsigned cvt_pk_bf16(float lo, float hi) { unsigned r; asm volatile("v_cvt_pk_bf16_f32 %0, %1, %2" : "=v"(r) : "v"(lo), "v"(hi)); return r; }
DI float bf_lo(unsigned w) { return __uint_as_float(w << 16); }
DI float bf_hi(unsigned w) { return __uint_as_float(w & 0xffff0000u); }
DI float sigm(float x) { return __builtin_amdgcn_rcpf(1.f + __expf(-x)); }
DI void unpack8(const u32x4 w, float* f) { f[0] = bf_lo(w.x); f[1] = bf_hi(w.x); f[2] = bf_lo(w.y); f[3] = bf_hi(w.y); f[4] = bf_lo(w.z); f[5] = bf_hi(w.z); f[6] = bf_lo(w.w); f[7] = bf_hi(w.w); }
#define LDS_WAIT() asm volatile("s_waitcnt lgkmcnt(0)" ::: "memory")

namespace pg8 {
#define PG8_LAS __attribute__((address_space(3)))
constexpr int BM = 256, BK = 64, HALF = 128, HTB = HALF * BK * 2, NXCD = 8, WGM = 8;
__host__ __device__ __forceinline__ int lds_byte(int r, int c) { const int st = (r >> 4) * 2 + (c >> 5), rr = r & 15, cc = c & 31, ob = rr * 64 + cc * 2; return st * 1024 + (ob ^ (((ob >> 9) & 1) << 5)); }
__host__ __device__ __forceinline__ void stage_rc(int b, int& R, int& C) { const int st = b / 1024, sb = b % 1024, swz = sb ^ (((sb >> 9) & 1) << 5); R = (st >> 1) * 16 + swz / 64; C = (st & 1) * 32 + (swz % 64) / 2; }
__host__ __device__ __forceinline__ int perm32(int rho) { const int n = rho >> 4, i = rho & 15; return 8 * (i >> 2) + 4 * n + (i & 3); }
struct Unit { int pm, pn; };
struct Gemm { const bf16_t* A; const bf16_t* Bt; int M, N, K, lda, ldb; };
struct StaticOrder {
    int nM, nN, nwg, G, c;
    __device__ void init(int M, int N, int G_, int c_) { nM = M / BM; nN = N / BM; nwg = nM * nN; G = G_; c = c_; }
    __device__ bool next(int i, Unit& u) const {
        const long L = (long)i * G + c; if (L >= nwg) return false;
        int wgid = (int)L; { const int q = nwg / NXCD, r = nwg % NXCD, xcd = wgid % NXCD, off = wgid / NXCD; wgid = (xcd < r ? xcd * (q + 1) : r * (q + 1) + (xcd - r) * q) + off; }
        const int nig = WGM * nN, gid = wgid / nig, fm = gid * WGM, gsz = (nM - fm) < WGM ? (nM - fm) : WGM;
        u.pm = fm + ((wgid % nig) % gsz); u.pn = (wgid % nig) / gsz; return true;
    }
};
template <class Epi, class Sched>
__device__ __forceinline__ void gemm_phase(PG8_LAS unsigned char* lds, const Gemm g, const Sched& S, const Epi& E) {
    int tid = threadIdx.x; asm volatile("" : "+v"(tid));
    const int wid = __builtin_amdgcn_readfirstlane(tid >> 6), lane = tid & 63, wr = wid >> 2, wc = wid & 3, fr = lane & 15, fq = lane >> 4;
    const int K = g.K, nt = K / BK;
    unsigned voffA[2], voffB[2];
#pragma unroll
    for (int i = 0; i < 2; ++i) { int R, C; stage_rc(tid * 16 + i * 8192, R, C); const int Rb = (R & ~31) + perm32(R & 31);
        voffA[i] = (unsigned)(R * g.lda + C) * 2u; voffB[i] = (unsigned)(Rb * g.ldb + C) * 2u; }
    const size_t kstep = (size_t)(BK * 2);
    const size_t hstepA = (size_t)HALF * g.lda * 2, hstepB = (size_t)HALF * g.ldb * 2;
    const size_t tstepA = 2 * hstepA, tstepB = 2 * hstepB;
    const unsigned ldsw = (unsigned)wid * 1024u;
    const int aoff = lds_byte(wr * 64 + fr, fq * 8), boff = lds_byte(wc * 32 + fr, fq * 8);
#define PG8_SA(b, h) (((b) * 2 + (h)) * HTB)
#define PG8_SB(b, h) ((4 + (b) * 2 + (h)) * HTB)
#define PG8_STAGE(bufoff, gbase, voff) do { _Pragma("unroll") for (int _i = 0; _i < 2; ++_i) \
        __builtin_amdgcn_global_load_lds((const unsigned*)((const char*)(gbase) + (voff)[_i]), (PG8_LAS unsigned*)(lds + (bufoff) + ldsw + _i * 8192), 16, 0, 0); } while (0)
#define PG8_LDA(dst, b, h) do { _Pragma("unroll") for (int m = 0; m < 4; ++m) _Pragma("unroll") for (int k = 0; k < 2; ++k) dst[m][k] = *(const PG8_LAS bf16x8*)(lds + PG8_SA(b, h) + aoff + m * 2048 + k * 1024); } while (0)
#define PG8_LDB(dst, b, h) do { _Pragma("unroll") for (int n = 0; n < 2; ++n) _Pragma("unroll") for (int k = 0; k < 2; ++k) dst[n][k] = *(const PG8_LAS bf16x8*)(lds + PG8_SB(b, h) + boff + n * 2048 + k * 1024); } while (0)
#define PG8_MMA(ai, bj, At, Bt) do { __builtin_amdgcn_s_setprio(1); _Pragma("unroll") for (int m = 0; m < 4; ++m) _Pragma("unroll") for (int n = 0; n < 2; ++n) _Pragma("unroll") for (int k = 0; k < 2; ++k) \
        acc[ai][bj][m][n] = __builtin_amdgcn_mfma_f32_16x16x32_bf16(Bt[n][k], At[m][k], acc[ai][bj][m][n], 0, 0, 0); __builtin_amdgcn_s_setprio(0); } while (0)
#define PG8_WAIT_V(n) asm volatile("s_waitcnt vmcnt(" #n ")" ::: "memory")
#define PG8_WAIT_L(n) asm volatile("s_waitcnt lgkmcnt(" #n ")" ::: "memory")
#define PG8_BAR __builtin_amdgcn_s_barrier()
#define PG8_SCHED __builtin_amdgcn_sched_barrier(0)
    Unit cur, nxt; int ui = 0;
    if (!S.next(0, cur)) return;
    f32x4 acc[2][2][4][2];
#pragma unroll
    for (int a = 0; a < 2; ++a)
#pragma unroll
        for (int b = 0; b < 2; ++b)
#pragma unroll
            for (int m = 0; m < 4; ++m)
#pragma unroll
                for (int n = 0; n < 2; ++n) acc[a][b][m][n] = (f32x4){0.f, 0.f, 0.f, 0.f};
    bf16x8 At[4][2], B0[2][2], B1[2][2];
    const char* cA = (const char*)g.A + (size_t)cur.pm * tstepA; const char* cB = (const char*)g.Bt + (size_t)cur.pn * tstepB;
    PG8_STAGE(PG8_SB(0, 0), cB, voffB); PG8_STAGE(PG8_SB(0, 1), cB + hstepB, voffB); PG8_STAGE(PG8_SA(0, 0), cA, voffA); PG8_STAGE(PG8_SA(0, 1), cA + hstepA, voffA);
    if (wr == 1) PG8_BAR;
    PG8_WAIT_V(2); PG8_BAR;
    PG8_STAGE(PG8_SB(1, 0), cB + kstep, voffB); PG8_STAGE(PG8_SA(1, 0), cA + kstep, voffA); PG8_STAGE(PG8_SB(1, 1), cB + hstepB + kstep, voffB);
    PG8_WAIT_V(6); PG8_BAR;
    for (;;) {
        const bool has_next = S.next(ui + 1, nxt);
        const char* nA = has_next ? (const char*)g.A + (size_t)nxt.pm * tstepA : cA; const char* nB = has_next ? (const char*)g.Bt + (size_t)nxt.pn * tstepB : cB;
        for (int t = 0; t < nt; t += 2) {
            const bool last = (t == nt - 2);
            const char* a1 = cA + (size_t)(t + 1) * kstep;
            const char* a2 = last ? nA : cA + (size_t)(t + 2) * kstep; const char* b2 = last ? nB : cB + (size_t)(t + 2) * kstep;
            const char* a3 = a2 + kstep; const char* b3 = b2 + kstep;
            PG8_LDB(B0, 0, 0); PG8_LDB(B1, 0, 1); PG8_SCHED; PG8_LDA(At, 0, 0); PG8_STAGE(PG8_SA(1, 1), a1 + hstepA, voffA);
            PG8_WAIT_V(8); PG8_WAIT_L(0); PG8_BAR; PG8_MMA(0, 0, At, B0); PG8_MMA(0, 1, At, B1); PG8_BAR; PG8_SCHED;
            PG8_LDA(At, 0, 1); PG8_STAGE(PG8_SB(0, 0), b2, voffB); PG8_STAGE(PG8_SB(0, 1), b2 + hstepB, voffB); PG8_STAGE(PG8_SA(0, 0), a2, voffA);
            PG8_WAIT_V(8); PG8_WAIT_L(0); PG8_BAR; PG8_MMA(1, 0, At, B0); PG8_MMA(1, 1, At, B1); PG8_BAR; PG8_SCHED;
            PG8_LDB(B0, 1, 0); PG8_LDB(B1, 1, 1); PG8_SCHED; PG8_LDA(At, 1, 0); PG8_STAGE(PG8_SA(0, 1), a2 + hstepA, voffA);
            PG8_WAIT_V(8); PG8_WAIT_L(0); PG8_BAR; PG8_MMA(0, 0, At, B0); PG8_MMA(0, 1, At, B1); PG8_BAR; PG8_SCHED;
            PG8_LDA(At, 1, 1); PG8_STAGE(PG8_SB(1, 0), b3, voffB); PG8_STAGE(PG8_SB(1, 1), b3 + hstepB, voffB); PG8_STAGE(PG8_SA(1, 0), a3, voffA);
            PG8_WAIT_V(8); PG8_WAIT_L(0); PG8_BAR; PG8_MMA(1, 0, At, B0); PG8_MMA(1, 1, At, B1); PG8_BAR; PG8_SCHED;
        }
        if (wr == 0) PG8_BAR;
        E(acc, cur, wr, wc, fr, fq);
        if (!has_next) break;
#pragma unroll
        for (int a = 0; a < 2; ++a)
#pragma unroll
            for (int b = 0; b < 2; ++b)
#pragma unroll
                for (int m = 0; m < 4; ++m)
#pragma unroll
                    for (int n = 0; n < 2; ++n) acc[a][b][m][n] = (f32x4){0.f, 0.f, 0.f, 0.f};
        cur = nxt; cA = nA; cB = nB; ++ui;
        if (wr == 1) PG8_BAR;
    }
    PG8_WAIT_V(0);
    PG8_BAR;
#undef PG8_SA
#undef PG8_SB
#undef PG8_STAGE
#undef PG8_LDA
#undef PG8_LDB
#undef PG8_MMA
#undef PG8_WAIT_V
#undef PG8_WAIT_L
#undef PG8_BAR
#undef PG8_SCHED
}
}
typedef f32x4 AccT[2][2][4][2];

struct EpiIn {
    bf16_t* Z; const u64* rowss; float* xch; const float* qw; const float* kw;
    DI void operator()(const AccT& acc, const pg8::Unit& u, int wr, int wc, int fr, int fq) const {
        const int row0 = u.pm * 256 + wr * 64 + fr, colt = u.pn * 256, blk = colt >> 10;
        bf16_t* base = Z + (size_t)blk * ZBLK + (colt & 1023) + wc * 32 + 8 * fq;
        const bool gate = blk >= 4;
        float rsv[8];
#pragma unroll
        for (int k = 0; k < 8; ++k) rsv[k] = (float)rowss[row0 + (k >> 2) * 128 + (k & 3) * 16] * RS_INV;
        if (blk == 1 || blk == 2) {
            const int wave = wr * 4 + wc;
            float part[16];
#pragma unroll
            for (int ai = 0; ai < 2; ++ai)
#pragma unroll
                for (int m = 0; m < 4; ++m) {
                    const float rs = rsqrtf(rsv[ai * 4 + m] * (1.f / DM) + 1e-6f);
                    rsv[ai * 4 + m] = rs;
#pragma unroll
                    for (int bj = 0; bj < 2; ++bj) {
                        const f32x4 v0 = acc[ai][bj][m][0] * rs, v1 = acc[ai][bj][m][1] * rs;
                        float ss = (v0[0] * v0[0] + v0[1] * v0[1]) + (v0[2] * v0[2] + v0[3] * v0[3]) + (v1[0] * v1[0] + v1[1] * v1[1]) + (v1[2] * v1[2] + v1[3] * v1[3]);
                        ss += __shfl_xor(ss, 16); ss += __shfl_xor(ss, 32);
                        part[(ai * 4 + m) * 2 + bj] = ss;
                    }
                }
            if (fq == 0) {
#pragma unroll
                for (int i = 0; i < 16; ++i) xch[(wave * 16 + i) * 16 + fr] = part[i];
            }
            asm volatile("s_waitcnt lgkmcnt(0)\n\ts_barrier" ::: "memory");
            const float* wsrc = (blk == 1 ? qw : kw) + (wc & 1) * 32 + 8 * fq;
            const float wsc = (blk == 1) ? 0.125f * 1.4426950408889634f : 1.f;
            const f32x4 w0 = *(const f32x4*)wsrc * wsc, w1 = *(const f32x4*)(wsrc + 4) * wsc;
#pragma unroll
            for (int ai = 0; ai < 2; ++ai)
#pragma unroll
                for (int m = 0; m < 4; ++m) {
                    const int row = row0 + ai * 128 + m * 16;
#pragma unroll
                    for (int bj = 0; bj < 2; ++bj) {
                        const int i = (ai * 4 + m) * 2 + bj;
                        const float tot = part[i] + xch[((wave ^ 1) * 16 + i) * 16 + fr];
                        const float sc = rsqrtf(tot * (1.f / 64.f) + 1e-6f) * rsv[ai * 4 + m];
                        const f32x4 v0 = acc[ai][bj][m][0] * sc * w0, v1 = acc[ai][bj][m][1] * sc * w1;
                        u32x4 w; w.x = cvt_pk_bf16(v0[0], v0[1]); w.y = cvt_pk_bf16(v0[2], v0[3]); w.z = cvt_pk_bf16(v1[0], v1[1]); w.w = cvt_pk_bf16(v1[2], v1[3]);
                        *(u32x4*)(base + (size_t)row * 1024 + bj * 128) = w;
                    }
                }
            return;
        }
#pragma unroll
        for (int ai = 0; ai < 2; ++ai)
#pragma unroll
            for (int m = 0; m < 4; ++m) {
                const int row = row0 + ai * 128 + m * 16;
                const float rs = rsqrtf(rsv[ai * 4 + m] * (1.f / DM) + 1e-6f);
#pragma unroll
                for (int bj = 0; bj < 2; ++bj) {
                    f32x4 v0 = acc[ai][bj][m][0] * rs, v1 = acc[ai][bj][m][1] * rs;
                    if (gate) {
#pragma unroll
                        for (int j = 0; j < 4; ++j) { v0[j] = fmaxf(sigm(v0[j]), 0.f); v1[j] = fmaxf(sigm(v1[j]), 0.f); }
                    }
                    u32x4 w; w.x = cvt_pk_bf16(v0[0], v0[1]); w.y = cvt_pk_bf16(v0[2], v0[3]); w.z = cvt_pk_bf16(v1[0], v1[1]); w.w = cvt_pk_bf16(v1[2], v1[3]);
                    *(u32x4*)(base + (size_t)row * 1024 + bj * 128) = w;
                }
            }
    }
};
struct EpiGlu {
    const bf16_t* YG; const float* bias; bf16_t* YY;
    DI void operator()(const AccT& acc, const pg8::Unit& u, int wr, int wc, int fr, int fq) const {
        const int row0 = u.pm * 256 + wr * 64 + fr, col0 = u.pn * 256 + wc * 32 + 8 * fq;
#pragma unroll
        for (int bj = 0; bj < 2; ++bj) {
            const int col = col0 + bj * 128;
            const f32x4 b0 = *(const f32x4*)(bias + col), b1 = *(const f32x4*)(bias + col + 4);
            u32x4 yv[8];
#pragma unroll
            for (int k = 0; k < 8; ++k) yv[k] = *(const u32x4*)(YG + (size_t)(row0 + (k >> 2) * 128 + (k & 3) * 16) * 1024 + col);
#pragma unroll
            for (int ai = 0; ai < 2; ++ai)
#pragma unroll
                for (int m = 0; m < 4; ++m) {
                    const int row = row0 + ai * 128 + m * 16;
                    float y[8]; unpack8(yv[ai * 4 + m], y);
                    const f32x4 a0 = acc[ai][bj][m][0] + b0, a1 = acc[ai][bj][m][1] + b1;
                    float o[8];
#pragma unroll
                    for (int j = 0; j < 4; ++j) { o[j] = y[j] * sigm(a0[j]); o[4 + j] = y[4 + j] * sigm(a1[j]); }
                    u32x4 w; w.x = cvt_pk_bf16(o[0], o[1]); w.y = cvt_pk_bf16(o[2], o[3]); w.z = cvt_pk_bf16(o[4], o[5]); w.w = cvt_pk_bf16(o[6], o[7]);
                    *(u32x4*)(YY + (size_t)row * 2048 + col) = w;
                }
        }
    }
};
struct EpiMerge {
    const bf16_t* G; bf16_t* MB; int second;
    DI void operator()(const AccT& acc, const pg8::Unit& u, int wr, int wc, int fr, int fq) const {
        const int row0 = u.pm * 256 + wr * 64 + fr, col0 = u.pn * 256 + wc * 32 + 8 * fq;
#pragma unroll
        for (int bj = 0; bj < 2; ++bj) {
            const int col = col0 + bj * 128;
            const bf16_t* gb = G + (size_t)(col >> 10) * ZBLK + (col & 1023);
#pragma unroll
            for (int ai = 0; ai < 2; ++ai) {
                u32x4 gv[4], pvv[4];
#pragma unroll
                for (int m = 0; m < 4; ++m) gv[m] = *(const u32x4*)(gb + (size_t)(row0 + ai * 128 + m * 16) * 1024);
                if (second) {
#pragma unroll
                    for (int m = 0; m < 4; ++m) pvv[m] = *(const u32x4*)(MB + (size_t)(row0 + ai * 128 + m * 16) * 2048 + col);
                }
#pragma unroll
                for (int m = 0; m < 4; ++m) {
                    const int row = row0 + ai * 128 + m * 16;
                    float gt[8]; unpack8(gv[m], gt);
                    float o[8];
#pragma unroll
                    for (int j = 0; j < 4; ++j) { o[j] = gt[j] * acc[ai][bj][m][0][j]; o[4 + j] = gt[4 + j] * acc[ai][bj][m][1][j]; }
                    if (second) { float pv[8]; unpack8(pvv[m], pv);
#pragma unroll
                        for (int j = 0; j < 8; ++j) o[j] += pv[j]; }
                    u32x4 w; w.x = cvt_pk_bf16(o[0], o[1]); w.y = cvt_pk_bf16(o[2], o[3]); w.z = cvt_pk_bf16(o[4], o[5]); w.w = cvt_pk_bf16(o[6], o[7]);
                    *(u32x4*)(MB + (size_t)row * 2048 + col) = w;
                }
            }
        }
    }
};
struct EpiRes {
    const float* xold; float* out; bf16_t* XB; u64* rowss; int emit;
    DI void operator()(const AccT& acc, const pg8::Unit& u, int wr, int wc, int fr, int fq) const {
        const int row0 = u.pm * 256 + wr * 64 + fr, col0 = u.pn * 256 + wc * 32 + 8 * fq;
#pragma unroll
        for (int am = 0; am < 4; ++am) {
            const int ai = am >> 1, mb = (am & 1) * 2;
            f32x4 xv[2][2][2];
#pragma unroll
            for (int m2 = 0; m2 < 2; ++m2)
#pragma unroll
                for (int bj = 0; bj < 2; ++bj) { const size_t off = (size_t)(row0 + ai * 128 + (mb + m2) * 16) * DM + col0 + bj * 128;
                    xv[m2][bj][0] = *(const f32x4*)(xold + off); xv[m2][bj][1] = *(const f32x4*)(xold + off + 4); }
#pragma unroll
            for (int m2 = 0; m2 < 2; ++m2) {
                const int m = mb + m2, row = row0 + ai * 128 + m * 16;
                float ss = 0.f;
#pragma unroll
                for (int bj = 0; bj < 2; ++bj) {
                    const size_t off = (size_t)row * DM + col0 + bj * 128;
                    const f32x4 x0 = xv[m2][bj][0] + acc[ai][bj][m][0], x1 = xv[m2][bj][1] + acc[ai][bj][m][1];
                    *(f32x4*)(out + off) = x0; *(f32x4*)(out + off + 4) = x1;
                    if (emit) {
                        u32x4 w; w.x = cvt_pk_bf16(x0[0], x0[1]); w.y = cvt_pk_bf16(x0[2], x0[3]); w.z = cvt_pk_bf16(x1[0], x1[1]); w.w = cvt_pk_bf16(x1[2], x1[3]);
                        *(u32x4*)(XB + off) = w;
                        ss += (x0[0] * x0[0] + x0[1] * x0[1]) + (x0[2] * x0[2] + x0[3] * x0[3]) + (x1[0] * x1[0] + x1[1] * x1[1]) + (x1[2] * x1[2] + x1[3] * x1[3]);
                    }
                }
                if (emit) {
                    ss += __shfl_xor(ss, 16); ss += __shfl_xor(ss, 32);
                    if (fq == 0) atomicAdd(rowss + row, (u64)(ss * RS_SCALE + 0.5f));
                }
            }
        }
    }
};
struct EpiUp {
    const u64* rowss; bf16_t* ACT;
    DI void operator()(const AccT& acc, const pg8::Unit& u, int wr, int wc, int fr, int fq) const {
        const int row0 = u.pm * 256 + wr * 64 + fr, ff0 = u.pn * 128 + wc * 32 + 8 * fq;
        float rsv[8];
#pragma unroll
        for (int k = 0; k < 8; ++k) rsv[k] = (float)rowss[row0 + (k >> 2) * 128 + (k & 3) * 16] * RS_INV;
#pragma unroll
        for (int ai = 0; ai < 2; ++ai)
#pragma unroll
            for (int m = 0; m < 4; ++m) {
                const int row = row0 + ai * 128 + m * 16;
                const float rs = rsqrtf(rsv[ai * 4 + m] * (1.f / DM) + 1e-6f);
                float o[8];
#pragma unroll
                for (int n = 0; n < 2; ++n) {
                    const f32x4 gv = acc[ai][0][m][n] * rs, uv = acc[ai][1][m][n] * rs;
#pragma unroll
                    for (int j = 0; j < 4; ++j) o[4 * n + j] = gv[j] * sigm(gv[j]) * uv[j];
                }
                u32x4 w; w.x = cvt_pk_bf16(o[0], o[1]); w.y = cvt_pk_bf16(o[2], o[3]); w.z = cvt_pk_bf16(o[4], o[5]); w.w = cvt_pk_bf16(o[6], o[7]);
                *(u32x4*)(ACT + (size_t)row * DFF + ff0) = w;
            }
    }
};

DI float wave_sum(float v) {
#pragma unroll
    for (int o = 1; o < 64; o <<= 1) v += __shfl_xor(v, o);
    return v;
}
DI void tr_item(const float* W, int N, const float* scale, bf16_t* WT, int ldk, int koff, int gu, int which, float* scr, int item, int lane) {
    const int nblk = N >> 6, kb = item / nblk, nb = item - kb * nblk, k0 = 64 * kb, n0 = 64 * nb;
    const int lr = lane >> 4, lc = (lane & 15) * 4;
    f32x4 v[16];
#pragma unroll
    for (int i = 0; i < 16; ++i) v[i] = *(const f32x4*)(W + (size_t)(k0 + 4 * i + lr) * N + n0 + lc);
#pragma unroll
    for (int i = 0; i < 16; ++i) { const int kk = 4 * i + lr; const float sc = scale ? scale[k0 + kk] : 1.f; float* d = scr + kk * 65 + lc;
        d[0] = v[i].x * sc; d[1] = v[i].y * sc; d[2] = v[i].z * sc; d[3] = v[i].w * sc; }
    LDS_WAIT();
    const int c = lane & 7;
#pragma unroll
    for (int j = 0; j < 8; ++j) { const int n = (lane >> 3) + 8 * j; const float* s = scr + (8 * c) * 65 + n;
        u32x4 o; o.x = cvt_pk_bf16(s[0 * 65], s[1 * 65]); o.y = cvt_pk_bf16(s[2 * 65], s[3 * 65]); o.z = cvt_pk_bf16(s[4 * 65], s[5 * 65]); o.w = cvt_pk_bf16(s[6 * 65], s[7 * 65]);
        const int nn = n0 + n; const int drow = gu ? (((nn >> 7) << 8) + which * 128 + (nn & 127)) : nn;
        *(u32x4*)(WT + (size_t)drow * ldk + koff + k0 + 8 * c) = o; }
    LDS_WAIT();
}

constexpr size_t SSM_GRP_BYTES = 262144, SSM_KC_OFF = 65536;
DI void ssm_build(PP P, int l, unsigned char* lds, int g, int cq, int tid) {
    float* PWr = (float*)lds; float* PWi = PWr + 17 * 64; float* BBr = PWi + 17 * 64; float* BBi = BBr + 1024; float* Cr = BBi + 1024; float* Ci = Cr + 1024; float* KT = Ci + 1024; float* Dk = KT + 4096;
    __syncthreads();
    if (tid < 64) {
        const int p = tid; const size_t gp = ((size_t)l * 64 + g) * 64 + p;
        const float lr = fminf(P->in[3][gp], -1e-4f), li = P->in[4][gp], dt = expf(P->in[5][l * 64 + g]);
        const float mag = expf(lr * dt), abr = mag * cosf(li * dt), abi = mag * sinf(li * dt);
        const float den = lr * lr + li * li, nr = abr - 1.f, ni = abi;
        const float fr = (nr * lr + ni * li) / den, fi = (ni * lr - nr * li) / den;
        float pr = 1.f, pi = 0.f;
        for (int d = 0; d < 17; ++d) { PWr[d * 64 + p] = pr; PWi[d * 64 + p] = pi; const float t = pr * abr - pi * abi; pi = pr * abi + pi * abr; pr = t; }
        for (int c = 0; c < 16; ++c) { const float br = P->in[6][gp * 16 + c], bi = P->in[7][gp * 16 + c]; BBr[p * 16 + c] = fr * br - fi * bi; BBi[p * 16 + c] = fr * bi + fi * br; }
        if (p < 16) Dk[p] = P->in[10][(size_t)l * 1024 + g * 16 + p];
    }
    for (int i = tid; i < 1024; i += 512) { Cr[i] = P->in[8][((size_t)l * 64 + g) * 1024 + i]; Ci[i] = P->in[9][((size_t)l * 64 + g) * 1024 + i]; }
    __syncthreads();
    for (int e = tid; e < 1024; e += 512) {
        const int d = e >> 6, c = (e >> 2) & 15, c2 = 4 * cq + (e & 3); float v = 0.f;
        for (int p = 0; p < 64; ++p) { const float cr = Cr[c * 64 + p], ci = Ci[c * 64 + p], pr = PWr[d * 64 + p], pi = PWi[d * 64 + p];
            v += (cr * pr - ci * pi) * BBr[p * 16 + c2] - (cr * pi + ci * pr) * BBi[p * 16 + c2]; }
        KT[d * 256 + c * 16 + c2] = v;
    }
    __syncthreads();
    bf16_t* BP = (bf16_t*)(P->ws + WS_SSMM + (size_t)g * SSM_GRP_BYTES); bf16_t* KC = (bf16_t*)(P->ws + WS_SSMM + (size_t)g * SSM_GRP_BYTES + SSM_KC_OFF);
    for (int q = tid; q < 256 * 16; q += 512) {
        const int row = q >> 4, i2 = q & 15, i = row >> 4, c = row & 15, c0 = 4 * cq; float v[4];
#pragma unroll
        for (int k = 0; k < 4; ++k) v[k] = (i2 <= i) ? KT[(i - i2) * 256 + c * 16 + c0 + k] + ((i2 == i && c0 + k == c) ? Dk[c] : 0.f) : 0.f;
        u32x2 w; w.x = cvt_pk_bf16(v[0], v[1]); w.y = cvt_pk_bf16(v[2], v[3]);
        *(u32x2*)(KC + (size_t)row * 384 + i2 * 16 + c0) = w;
    }
    for (int q = tid; q < 256 * 4; q += 512) {
        const int row = q >> 2, col8 = 32 * cq + (q & 3) * 8, i = row >> 4, c = row & 15; const bool im = col8 >= 64; const int p0 = col8 & 63; float v[8];
#pragma unroll
        for (int k = 0; k < 8; ++k) { const float cr = Cr[c * 64 + p0 + k], ci = Ci[c * 64 + p0 + k], pr = PWr[(i + 1) * 64 + p0 + k], pi = PWi[(i + 1) * 64 + p0 + k];
            v[k] = im ? -(cr * pi + ci * pr) : (cr * pr - ci * pi); }
        u32x4 w; w.x = cvt_pk_bf16(v[0], v[1]); w.y = cvt_pk_bf16(v[2], v[3]); w.z = cvt_pk_bf16(v[4], v[5]); w.w = cvt_pk_bf16(v[6], v[7]);
        *(u32x4*)(KC + (size_t)row * 384 + 256 + col8) = w;
    }
    for (int q = tid; q < 128 * 16; q += 512) {
        const int rr = q >> 4, i2 = q & 15, c0 = 4 * cq, p = rr & 63, d = 15 - i2; const bool im = rr >= 64;
        const float pr = PWr[d * 64 + p], pi = PWi[d * 64 + p]; float v[4];
#pragma unroll
        for (int k = 0; k < 4; ++k) { const float br = BBr[p * 16 + c0 + k], bi = BBi[p * 16 + c0 + k]; v[k] = im ? (pr * bi + pi * br) : (pr * br - pi * bi); }
        u32x2 w; w.x = cvt_pk_bf16(v[0], v[1]); w.y = cvt_pk_bf16(v[2], v[3]);
        *(u32x2*)(BP + (size_t)rr * 256 + i2 * 16 + c0) = w;
    }
    __syncthreads();
}

DI void conv_phase(PP P, int l, unsigned char* lds, int G, int cid) {
    int tid = threadIdx.x; asm volatile("" : "+v"(tid));
    const int lane = tid & 63, wave = tid >> 6;
    const int gw = cid * 8 + wave, NGW = G * 8;
    float* scr = (float*)(lds + wave * 16640);
    unsigned char* ws = P->ws;
    for (int w = cid; w < 256; w += G) ssm_build(P, l, lds, w >> 2, w & 3, tid);
    constexpr int I1 = 32 * 128, I2 = 16 * 16, I3 = 16 * 32, I4 = I3, I5 = 32 * 32, I6 = 32 * 88, I7 = I6, I8 = 88 * 32;
    constexpr int NIT = I1 + I2 + I3 + I4 + I5 + I6 + I7 + I8;
    const float* n1 = P->in[1] + (size_t)l * DM; const float* n2 = P->in[24] + (size_t)l * DM;
    for (int it = gw; it < NIT; it += NGW) {
        int r = it;
        if (r < I1) { tr_item(P->in[2] + (size_t)l * DM * NIN, NIN, n1, (bf16_t*)(ws + WS_WIN), DM, 0, 0, 0, scr, r, lane); continue; } r -= I1;
        if (r < I2) { tr_item(P->in[11] + (size_t)l * 1024 * 1024, 1024, nullptr, (bf16_t*)(ws + WS_WGLU), 1024, 0, 0, 0, scr, r, lane); continue; } r -= I2;
        if (r < I3) { tr_item(P->in[20] + (size_t)l * 1024 * DM, DM, nullptr, (bf16_t*)(ws + WS_WM), 2048, 0, 0, 0, scr, r, lane); continue; } r -= I3;
        if (r < I4) { tr_item(P->in[21] + (size_t)l * 1024 * DM, DM, nullptr, (bf16_t*)(ws + WS_WM), 2048, 1024, 0, 0, scr, r, lane); continue; } r -= I4;
        if (r < I5) { tr_item(P->in[22] + (size_t)l * DM * DM, DM, nullptr, (bf16_t*)(ws + WS_WOUT), DM, 0, 0, 0, scr, r, lane); continue; } r -= I5;
        if (r < I6) { tr_item(P->in[25] + (size_t)l * DM * DFF, DFF, n2, (bf16_t*)(ws + WS_WGU), DM, 0, 1, 0, scr, r, lane); continue; } r -= I6;
        if (r < I7) { tr_item(P->in[26] + (size_t)l * DM * DFF, DFF, n2, (bf16_t*)(ws + WS_WGU), DM, 0, 1, 1, scr, r, lane); continue; } r -= I7;
        tr_item(P->in[27] + (size_t)l * DFF * DM, DM, nullptr, (bf16_t*)(ws + WS_WDN), DFF, 0, 0, 0, scr, r, lane);
    }
    if (l == 0) {
        u64* rowss = (u64*)(ws + WS_ROWSS);
        for (int i = cid * 512 + tid; i < 3 * MTOK; i += G * 512) rowss[MTOK + i] = 0u;
        const float* x = P->in[0]; bf16_t* XB = (bf16_t*)(ws + WS_XB);
        for (int m = gw; m < MTOK; m += NGW) {
            const f32x4* xr = (const f32x4*)(x + (size_t)m * DM) + lane;
            f32x4 v[8]; float s = 0.f;
#pragma unroll
            for (int j = 0; j < 8; ++j) { v[j] = xr[64 * j]; s += (v[j].x * v[j].x + v[j].y * v[j].y) + (v[j].z * v[j].z + v[j].w * v[j].w); }
            s = wave_sum(s);
            if (lane == 0) rowss[m] = (u64)(s * RS_SCALE + 0.5f);
            u32x2* o = (u32x2*)(XB + (size_t)m * DM) + lane;
#pragma unroll
            for (int j = 0; j < 8; ++j) { u32x2 w; w.x = cvt_pk_bf16(v[j].x, v[j].y); w.y = cvt_pk_bf16(v[j].z, v[j].w); o[64 * j] = w; }
        }
    }
}

DI void ssm_phase(PP P, int l, unsigned char* lds, int G, int cid) {
    int tid = threadIdx.x; asm volatile("" : "+v"(tid));
    const int lane = tid & 63, wave = tid >> 6;
    float* E = (float*)lds;
    const bf16_t* ZU = (const bf16_t*)(P->ws + WS_Z);
    bf16_t* YG = (bf16_t*)(P->ws + WS_YG);
    for (int bg = cid; bg < NB * 64; bg += G) {
        const int b = bg >> 6, g = bg & 63, p = lane;
        const size_t gp = ((size_t)l * 64 + g) * 64 + p;
        const float lr = fminf(P->in[3][gp], -1e-4f), li = P->in[4][gp], dt = expf(P->in[5][l * 64 + g]);
        const float mag = expf(lr * dt), abr = mag * cosf(li * dt), abi = mag * sinf(li * dt);
        const float den = lr * lr + li * li, nr = abr - 1.f, ni = abi;
        const float fr = (nr * lr + ni * li) / den, fi = (ni * lr - nr * li) / den;
        float bbr[16], bbi[16], cr[16], ci[16];
#pragma unroll
        for (int c = 0; c < 16; ++c) {
            const float br = P->in[6][gp * 16 + c], bi = P->in[7][gp * 16 + c];
            bbr[c] = fr * br - fi * bi; bbi[c] = fr * bi + fi * br;
            cr[c] = P->in[8][(((size_t)l * 64 + g) * 16 + c) * 64 + p]; ci[c] = P->in[9][(((size_t)l * 64 + g) * 16 + c) * 64 + p];
        }
        const int cme = (lane >> 2) & 15;
        const float dme = P->in[10][(size_t)l * 1024 + g * 16 + cme];
        const int t0 = wave * 512;
        int vz = 0; asm volatile("" : "+v"(vz));
        const bf16_t* ub = ZU + ((size_t)b * SEQ + t0) * 1024 + g * 16 + vz;
        float sr = 0.f, si = 0.f;
        {
            u32x4 w0 = *(const u32x4*)ub, w1 = *(const u32x4*)(ub + 8);
            for (int t = 0; t < 512; ++t) {
                float u[16]; unpack8(w0, u); unpack8(w1, u + 8);
                const int tn = (t + 1 < 512) ? t + 1 : t;
                w0 = *(const u32x4*)(ub + (size_t)tn * 1024); w1 = *(const u32x4*)(ub + (size_t)tn * 1024 + 8);
                float bur = 0.f, bui = 0.f;
#pragma unroll
                for (int c = 0; c < 16; ++c) { bur += bbr[c] * u[c]; bui += bbi[c] * u[c]; }
                const float nsr = abr * sr - abi * si + bur, nsi = abr * si + abi * sr + bui;
                sr = nsr; si = nsi;
            }
        }
        __syncthreads();
        E[(wave * 64 + p) * 2] = sr; E[(wave * 64 + p) * 2 + 1] = si;
        float pr = abr, pi = abi;
#pragma unroll
        for (int i = 0; i < 9; ++i) { const float t = pr * pr - pi * pi; pi = 2.f * pr * pi; pr = t; }
        __syncthreads();
        sr = 0.f; si = 0.f;
        for (int w = 0; w < wave; ++w) { const float er = E[(w * 64 + p) * 2], ei = E[(w * 64 + p) * 2 + 1]; const float t = pr * sr - pi * si + er; si = pr * si + pi * sr + ei; sr = t; }
        {
            u32x4 w0 = *(const u32x4*)ub, w1 = *(const u32x4*)(ub + 8);
            for (int t = 0; t < 512; ++t) {
                float u[16]; unpack8(w0, u); unpack8(w1, u + 8);
                const int tn = (t + 1 < 512) ? t + 1 : t;
                w0 = *(const u32x4*)(ub + (size_t)tn * 1024); w1 = *(const u32x4*)(ub + (size_t)tn * 1024 + 8);
                float bur = 0.f, bui = 0.f;
#pragma unroll
                for (int c = 0; c < 16; ++c) { bur += bbr[c] * u[c]; bui += bbi[c] * u[c]; }
                const float nsr = abr * sr - abi * si + bur, nsi = abr * si + abi * sr + bui;
                sr = nsr; si = nsi;
                float w[16];
#pragma unroll
                for (int c = 0; c < 16; ++c) w[c] = cr[c] * sr - ci[c] * si;
                float w8[8], w4[4], w2[2], w1v;
                { const bool hi = lane & 32;
#pragma unroll
                  for (int j = 0; j < 8; ++j) { const float keep = hi ? w[8 + j] : w[j], send = hi ? w[j] : w[8 + j]; w8[j] = keep + __shfl_xor(send, 32); } }
                { const bool hi = lane & 16;
#pragma unroll
                  for (int j = 0; j < 4; ++j) { const float keep = hi ? w8[4 + j] : w8[j], send = hi ? w8[j] : w8[4 + j]; w4[j] = keep + __shfl_xor(send, 16); } }
                { const bool hi = lane & 8;
#pragma unroll
                  for (int j = 0; j < 2; ++j) { const float keep = hi ? w4[2 + j] : w4[j], send = hi ? w4[j] : w4[2 + j]; w2[j] = keep + __shfl_xor(send, 8); } }
                { const bool hi = lane & 4; const float keep = hi ? w2[1] : w2[0], send = hi ? w2[0] : w2[1]; w1v = keep + __shfl_xor(send, 4); }
                w1v += __shfl_xor(w1v, 2); w1v += __shfl_xor(w1v, 1);
                float ume = 0.f;
#pragma unroll
                for (int c = 0; c < 16; ++c) ume = (cme == c) ? u[c] : ume;
                const float y = w1v + dme * ume;
                const float gl = y * sigm(1.5957691216f * (y + 0.044715f * y * y * y));
                if ((lane & 3) == 0) YG[((size_t)b * SEQ + t0 + t) * 1024 + g * 16 + cme] = (bf16_t)(cvt_pk_bf16(gl, gl) & 0xffffu);
            }
        }
        __syncthreads();
    }
}


#define MFMA16(a, b, c) __builtin_amdgcn_mfma_f32_16x16x32_bf16((a), (b), (c), 0, 0, 0)
constexpr int SS_UL = 0, SS_SL = 33792, SS_EL = 33792 + 17408;
DI void ssm_mfma_phase(PP P, int l, unsigned char* lds, int G, int cid) {
    int tid = threadIdx.x; asm volatile("" : "+v"(tid));
    const int lane = tid & 63, wave = __builtin_amdgcn_readfirstlane(tid >> 6), n16 = lane & 15, q4 = lane >> 4;
    bf16_t* UL = (bf16_t*)(lds + SS_UL); bf16_t* SL = (bf16_t*)(lds + SS_SL); float* EL = (float*)(lds + SS_EL);
    const bf16_t* ZU = (const bf16_t*)(P->ws + WS_Z);
    bf16_t* YG = (bf16_t*)(P->ws + WS_YG);
    for (int bg = cid; bg < NB * 64; bg += G) {
        const int b = bg >> 6, g = bg & 63;
        const bf16_t* BP = (const bf16_t*)(P->ws + WS_SSMM + (size_t)g * SSM_GRP_BYTES); const bf16_t* KC = (const bf16_t*)(P->ws + WS_SSMM + (size_t)g * SSM_GRP_BYTES + SSM_KC_OFF);
        bf16x8 abp[8], akc[2][12];
#pragma unroll
        for (int ks = 0; ks < 8; ++ks) abp[ks] = *(const bf16x8*)(BP + (size_t)(wave * 16 + n16) * 256 + ks * 32 + q4 * 8);
#pragma unroll
        for (int rt = 0; rt < 2; ++rt)
#pragma unroll
            for (int ks = 0; ks < 12; ++ks) akc[rt][ks] = *(const bf16x8*)(KC + (size_t)((wave * 2 + rt) * 16 + n16) * 384 + ks * 32 + q4 * 8);
        float a16r = 1.f, a16i = 0.f, sr = 0.f, si = 0.f;
        if (wave == 0) {
            const int p = lane; const size_t gp = ((size_t)l * 64 + g) * 64 + p;
            const float lr = fminf(P->in[3][gp], -1e-4f), li = P->in[4][gp], dt = expf(P->in[5][l * 64 + g]);
            const float mag = expf(lr * dt); a16r = mag * cosf(li * dt); a16i = mag * sinf(li * dt);
#pragma unroll
            for (int i = 0; i < 4; ++i) { const float t = a16r * a16r - a16i * a16i; a16i = 2.f * a16r * a16i; a16r = t; }
        }
        for (int qt = 0; qt < 4; ++qt) {
            __syncthreads();
#pragma unroll
            for (int k = 0; k < 2; ++k) { const int t = tid + 512 * k;
                const bf16_t* up = ZU + ((size_t)b * SEQ + qt * 1024 + t) * 1024 + g * 16;
                const u32x4 w0 = *(const u32x4*)up, w1 = *(const u32x4*)(up + 8);
                bf16_t* dp = UL + (t >> 4) * 264 + (t & 15) * 16; *(u32x4*)dp = w0; *(u32x4*)(dp + 8) = w1; }
            __syncthreads();
#pragma unroll
            for (int jt = 0; jt < 4; ++jt) {
                f32x4 acc = {0.f, 0.f, 0.f, 0.f};
#pragma unroll
                for (int ks = 0; ks < 8; ++ks) { const bf16x8 bf = *(const bf16x8*)(UL + (jt * 16 + n16) * 264 + ks * 32 + q4 * 8); acc = MFMA16(abp[ks], bf, acc); }
                *(f32x4*)(EL + (jt * 16 + n16) * 128 + wave * 16 + 4 * q4) = acc;
            }
            __syncthreads();
            if (wave == 0) {
#pragma unroll 1
                for (int jb = 0; jb < 64; jb += 16) {
                    float er[16], ei[16];
#pragma unroll
                    for (int k = 0; k < 16; ++k) { er[k] = EL[(jb + k) * 128 + lane]; ei[k] = EL[(jb + k) * 128 + 64 + lane]; }
#pragma unroll
                    for (int k = 0; k < 16; ++k) {
                        SL[(jb + k) * 136 + lane] = (bf16_t)(cvt_pk_bf16(sr, sr) & 0xffffu); SL[(jb + k) * 136 + 64 + lane] = (bf16_t)(cvt_pk_bf16(si, si) & 0xffffu);
                        const float t = a16r * sr - a16i * si + er[k]; si = a16r * si + a16i * sr + ei[k]; sr = t;
                    }
                }
            }
            __syncthreads();
#pragma unroll
            for (int rt = 0; rt < 2; ++rt)
#pragma unroll
                for (int jt = 0; jt < 4; ++jt) {
                    f32x4 acc = {0.f, 0.f, 0.f, 0.f};
#pragma unroll
                    for (int ks = 0; ks < 8; ++ks) { const bf16x8 bf = *(const bf16x8*)(UL + (jt * 16 + n16) * 264 + ks * 32 + q4 * 8); acc = MFMA16(akc[rt][ks], bf, acc); }
#pragma unroll
                    for (int ks = 0; ks < 4; ++ks) { const bf16x8 bf = *(const bf16x8*)(SL + (jt * 16 + n16) * 136 + ks * 32 + q4 * 8); acc = MFMA16(akc[rt][8 + ks], bf, acc); }
                    float o[4];
#pragma unroll
                    for (int k = 0; k < 4; ++k) { const float y = acc[k]; o[k] = y * sigm(1.5957691216f * (y + 0.044715f * y * y * y)); }
                    u32x2 w; w.x = cvt_pk_bf16(o[0], o[1]); w.y = cvt_pk_bf16(o[2], o[3]);
                    const int t = qt * 1024 + (jt * 16 + n16) * 16 + (wave * 2 + rt);
                    *(u32x2*)(YG + ((size_t)b * SEQ + t) * 1024 + g * 16 + 4 * q4) = w;
                }
        }
    }
    __syncthreads();
}

DI int t5_bucket(int rel) {
    const int ret = rel > 0 ? 16 : 0; const int n = rel < 0 ? -rel : rel;
    int v;
    if (n < 8) v = n;
    else { const float f = logf((float)n / 8.f) / logf(16.f) * 8.f; int lg = 8 + (int)(f + 1e-4f); v = lg < 15 ? lg : 15; }
    return ret + v;
}
DI void attn_phase(PP P, int l, unsigned char* lds, int G, int cid) {
    int tid = threadIdx.x; asm volatile("" : "+v"(tid));
    const int lane = tid & 63;
    float* Ks = (float*)lds;
    float* Vs = Ks + 64 * 128;
    float* tb = Vs + 64 * 128;
    float* red = tb + 192;
    float* Ox = Ks;
    const bf16_t* Zq = (const bf16_t*)(P->ws + WS_Z) + 1 * ZBLK; const bf16_t* Zk = Zq + ZBLK; const bf16_t* Zv = Zk + ZBLK;
    bf16_t* YY = (bf16_t*)(P->ws + WS_YY);
    const float* qw = P->in[13] + l * 64; const float* kw = P->in[14] + l * 64;
    const float linit = (l == 0) ? 0.2f : 0.35550906759096926f;
    float d1 = 0.f, d2 = 0.f, mq = 0.f, mk = 0.f;
    for (int i = 0; i < 64; ++i) { d1 += P->in[15][l * 64 + i] * P->in[16][l * 64 + i]; d2 += P->in[17][l * 64 + i] * P->in[18][l * 64 + i]; mq = fmaxf(mq, fabsf(qw[i])); mk = fmaxf(mk, fabsf(kw[i])); }
    const float lam = expf(d1) - expf(d2) + linit;
    const int row = tid & 63, map = (tid >> 6) & 1, eq = tid >> 7;
    for (int u = cid; u < 2048; u += G) {
        const int w = u & 255, i = u >> 8, bh = w >> 3, r = w & 7, b = bh >> 3, h = bh & 7;
        const int c = (i >> 1) * 16 + ((i & 1) ? 15 - r : r);
        float mb = 0.f;
        for (int k = 0; k < 32; ++k) mb = fmaxf(mb, fabsf(P->in[23][k * 8 + h]));
        const float smax = 8.f * mq * mk + mb;
        __syncthreads();
        if (tid < 192) tb[tid] = P->in[23][t5_bucket(tid - 128) * 8 + h];
        float q[64];
        {
            const bf16_t* qp = Zq + ((size_t)b * SEQ + c * 64 + row) * 1024 + h * 128 + map * 64;
            float ss = 0.f;
#pragma unroll
            for (int j = 0; j < 8; ++j) { unpack8(*(const u32x4*)(qp + 8 * j), q + 8 * j); }
#pragma unroll
            for (int d = 0; d < 64; ++d) ss += q[d] * q[d];
            const float rs = rsqrtf(ss * (1.f / 64.f) + 1e-6f) * 0.125f;
#pragma unroll
            for (int d = 0; d < 64; ++d) q[d] = q[d] * rs * qw[d];
        }
        float o[32], lsum = 0.f;
#pragma unroll
        for (int e = 0; e < 32; ++e) o[e] = 0.f;
        for (int kt = 0; kt <= c; ++kt) {
            __syncthreads();
            {
                const int pair = tid >> 2, key = pair >> 1, mp = pair & 1, d0 = (tid & 3) * 16;
                const bf16_t* kp = Zk + ((size_t)b * SEQ + kt * 64 + key) * 1024 + h * 128 + mp * 64 + d0;
                float kv[16]; unpack8(*(const u32x4*)kp, kv); unpack8(*(const u32x4*)(kp + 8), kv + 8);
                float ss = 0.f;
#pragma unroll
                for (int d = 0; d < 16; ++d) ss += kv[d] * kv[d];
                ss += __shfl_xor(ss, 1); ss += __shfl_xor(ss, 2);
                const float rs = rsqrtf(ss * (1.f / 64.f) + 1e-6f);
#pragma unroll
                for (int d = 0; d < 16; ++d) Ks[key * 128 + mp * 64 + d0 + d] = kv[d] * rs * kw[d0 + d];
                const int vkey = tid >> 3, e0 = (tid & 7) * 16;
                const bf16_t* vp = Zv + ((size_t)b * SEQ + kt * 64 + vkey) * 1024 + h * 128 + e0;
                float vv[16]; unpack8(*(const u32x4*)vp, vv); unpack8(*(const u32x4*)(vp + 8), vv + 8);
#pragma unroll
                for (int d = 0; d < 16; ++d) Vs[vkey * 128 + e0 + d] = vv[d];
            }
            __syncthreads();
            for (int j = 0; j < 64; ++j) {
                const f32x4* kr = (const f32x4*)(Ks + j * 128 + map * 64);
                float s = 0.f;
#pragma unroll
                for (int d4 = 0; d4 < 16; ++d4) { const f32x4 kk = kr[d4]; s += q[4 * d4] * kk.x + q[4 * d4 + 1] * kk.y + q[4 * d4 + 2] * kk.z + q[4 * d4 + 3] * kk.w; }
                int rel = (kt - c) * 64 + j - row; rel = rel < -128 ? -128 : rel;
                s += tb[rel + 128];
                const float pexp = __expf(s - smax);
                lsum += pexp;
                const f32x4* vr = (const f32x4*)(Vs + j * 128 + eq * 32);
#pragma unroll
                for (int e4 = 0; e4 < 8; ++e4) { const f32x4 vv = vr[e4]; o[4 * e4] += pexp * vv.x; o[4 * e4 + 1] += pexp * vv.y; o[4 * e4 + 2] += pexp * vv.z; o[4 * e4 + 3] += pexp * vv.w; }
            }
        }
        __syncthreads();
        {
            const float inv = 1.f / lsum;
#pragma unroll
            for (int e = 0; e < 32; ++e) Ox[(map * 64 + row) * 129 + eq * 32 + e] = o[e] * inv;
        }
        __syncthreads();
        {
            const int part = tid >> 6, e0 = part * 16;
            float val[16], ssq = 0.f;
#pragma unroll
            for (int e = 0; e < 16; ++e) { val[e] = Ox[row * 129 + e0 + e] - lam * Ox[(64 + row) * 129 + e0 + e]; ssq += val[e] * val[e]; }
            red[row * 8 + part] = ssq;
            __syncthreads();
            float tot = 0.f;
#pragma unroll
            for (int k = 0; k < 8; ++k) tot += red[row * 8 + k];
            const float rs = rsqrtf(tot * (1.f / 128.f) + 1e-5f) * (1.f - linit);
            const float* sw = P->in[19] + l * 128 + e0;
            bf16_t* op = YY + ((size_t)b * SEQ + c * 64 + row) * 2048 + 1024 + h * 128 + e0;
            u32x4 w0, w1;
            w0.x = cvt_pk_bf16(val[0] * rs * sw[0], val[1] * rs * sw[1]); w0.y = cvt_pk_bf16(val[2] * rs * sw[2], val[3] * rs * sw[3]);
            w0.z = cvt_pk_bf16(val[4] * rs * sw[4], val[5] * rs * sw[5]); w0.w = cvt_pk_bf16(val[6] * rs * sw[6], val[7] * rs * sw[7]);
            w1.x = cvt_pk_bf16(val[8] * rs * sw[8], val[9] * rs * sw[9]); w1.y = cvt_pk_bf16(val[10] * rs * sw[10], val[11] * rs * sw[11]);
            w1.z = cvt_pk_bf16(val[12] * rs * sw[12], val[13] * rs * sw[13]); w1.w = cvt_pk_bf16(val[14] * rs * sw[14], val[15] * rs * sw[15]);
            *(u32x4*)op = w0; *(u32x4*)(op + 8) = w1;
        }
    }
    __syncthreads();
}


constexpr float LOG2E = 1.4426950408889634f;
DI void prep_phase(PP P, int l, unsigned char* lds, int G, int cid) {
    int tid = threadIdx.x; asm volatile("" : "+v"(tid));
    const int lane = tid & 63, wave = tid >> 6;
    const int gw = cid * 8 + wave, NGW = G * 8;
    const bf16_t* Zv = (const bf16_t*)(P->ws + WS_Z) + 3 * ZBLK;
    bf16_t* VT = (bf16_t*)(P->ws + WS_VT);
    bf16_t* tile = (bf16_t*)(lds + wave * 18432);
    for (int it = gw; it < 2048; it += NGW) {
        const int bh = it >> 6, tt = it & 63, b = bh >> 3, h = bh & 7;
#pragma unroll
        for (int i = 0; i < 16; ++i) { const int t = 4 * i + (lane >> 4), ch = lane & 15;
            const u32x4 w = *(const u32x4*)(Zv + ((size_t)b * SEQ + tt * 64 + t) * 1024 + h * 128 + ch * 8);
            *(u32x4*)(tile + t * 136 + ch * 8) = w; }
        LDS_WAIT();
#pragma unroll 2
        for (int ps = 0; ps < 16; ++ps) { const int e = ps * 8 + (lane >> 3), c8 = lane & 7;
            const bf16_t* tp = tile + (c8 * 8) * 136 + e;
            u32x4 w;
            w.x = (unsigned)tp[0] | ((unsigned)tp[136] << 16); w.y = (unsigned)tp[2 * 136] | ((unsigned)tp[3 * 136] << 16);
            w.z = (unsigned)tp[4 * 136] | ((unsigned)tp[5 * 136] << 16); w.w = (unsigned)tp[6 * 136] | ((unsigned)tp[7 * 136] << 16);
            *(u32x4*)(VT + ((size_t)bh * 128 + e) * SEQ + tt * 64 + c8 * 8) = w; }
        LDS_WAIT();
    }
}

typedef float f32x16 __attribute__((ext_vector_type(16)));
typedef float f32x2v __attribute__((ext_vector_type(2)));
typedef __bf16 bf16x2v __attribute__((ext_vector_type(2)));
DI unsigned pk_bf16(float lo, float hi) { f32x2v v = {lo, hi}; bf16x2v b = __builtin_convertvector(v, bf16x2v); return __builtin_bit_cast(unsigned, b); }
DI bf16x8 pack8(const f32x16& x, int s) {
    u32x4 p; p.x = pk_bf16(x[8 * s], x[8 * s + 1]); p.y = pk_bf16(x[8 * s + 2], x[8 * s + 3]); p.z = pk_bf16(x[8 * s + 4], x[8 * s + 5]); p.w = pk_bf16(x[8 * s + 6], x[8 * s + 7]);
    return __builtin_bit_cast(bf16x8, p);
}
#define MFMA32(a, b, c) __builtin_amdgcn_mfma_f32_32x32x16_bf16((a), (b), (c), 0, 0, 0)
constexpr int AT_KS = 16384, AT_V0 = 32768, AT_TB = 65536;
typedef __attribute__((address_space(3))) unsigned char* ldsp_t;
template <bool NEAR>
DI void attn_qk(f32x16& s0, f32x16& s1, ldsp_t kb, const int* kro, const bf16x8* qf, int dtile, const float* tb2, int hi, int qg, int r32) {
    bf16x8 a[8];
#pragma unroll
    for (int ks = 0; ks < 4; ++ks) { a[2 * ks] = *(const __attribute__((address_space(3))) bf16x8*)(kb + kro[ks]); a[2 * ks + 1] = *(const __attribute__((address_space(3))) bf16x8*)(kb + kro[ks] + 8192); }
    if (!NEAR) {
        const float c0 = tb2[0];
#pragma unroll
        for (int k = 0; k < 16; ++k) { s0[k] = c0; s1[k] = c0; }
    } else {
        const int base = dtile * 64 + 8 * hi - (qg & 1) * 32 - r32 + 128;
#pragma unroll
        for (int k = 0; k < 16; ++k) { const int i0 = base + (k & 7) + 16 * (k >> 3), i1 = i0 + 32; s0[k] = tb2[i0 < 0 ? 0 : i0]; s1[k] = tb2[i1 < 0 ? 0 : i1]; }
    }
#pragma unroll
    for (int ks = 0; ks < 4; ++ks) { s0 = MFMA32(a[2 * ks], qf[ks], s0); s1 = MFMA32(a[2 * ks + 1], qf[ks], s1); }
}
DI void attn_pv(f32x16& s0, f32x16& s1, ldsp_t vb, const int* vro, f32x16* o, float& lsum) {
#pragma unroll
    for (int k = 0; k < 16; ++k) { s0[k] = __builtin_amdgcn_exp2f(s0[k]); s1[k] = __builtin_amdgcn_exp2f(s1[k]); }
    float ps = 0.f;
#pragma unroll
    for (int k = 0; k < 16; ++k) ps += s0[k] + s1[k];
    lsum += ps;
    bf16x8 pk[4]; pk[0] = pack8(s0, 0); pk[1] = pack8(s0, 1); pk[2] = pack8(s1, 0); pk[3] = pack8(s1, 1);
#pragma unroll
    for (int kk = 0; kk < 4; ++kk)
#pragma unroll
        for (int et = 0; et < 4; ++et) {
            const bf16x8 a = *(const __attribute__((address_space(3))) bf16x8*)(vb + vro[kk] + et * 4096);
            o[et] = MFMA32(a, pk[kk], o[et]);
        }
}
#define AT_DMA(gp, dst) __builtin_amdgcn_global_load_lds((const unsigned*)(gp), (__attribute__((address_space(3))) unsigned*)(dst), 16, 0, 0)
DI void attn_mfma_phase(PP P, int l, unsigned char* lds, int G, int cid) {
    int tid = threadIdx.x; asm volatile("" : "+v"(tid));
    const int lane = tid & 63, wave = __builtin_amdgcn_readfirstlane(tid >> 6), r32 = lane & 31, hi = lane >> 5, qg = wave & 3, map = wave >> 2;
    ldsp_t ldsl = (ldsp_t)lds;
    float* tb2 = (float*)(lds + AT_TB);
    float* OX = (float*)lds;
    const bf16_t* Zq = (const bf16_t*)(P->ws + WS_Z) + ZBLK; const bf16_t* Zk = Zq + ZBLK;
    const bf16_t* VT = (const bf16_t*)(P->ws + WS_VT);
    bf16_t* YY = (bf16_t*)(P->ws + WS_YY);
    const float linit = (l == 0) ? 0.2f : 0.35550906759096926f;
    float d1 = 0.f, d2 = 0.f, mq = 0.f, mk = 0.f;
    for (int i = 0; i < 64; ++i) { d1 += P->in[15][l * 64 + i] * P->in[16][l * 64 + i]; d2 += P->in[17][l * 64 + i] * P->in[18][l * 64 + i];
        mq = fmaxf(mq, fabsf(P->in[13][l * 64 + i])); mk = fmaxf(mk, fabsf(P->in[14][l * 64 + i])); }
    const float lam = expf(d1) - expf(d2) + linit;
    const int pir = (r32 & ~12) | ((r32 & 4) << 1) | ((r32 & 8) >> 1);
    int kro[4], vro[4];
#pragma unroll
    for (int k = 0; k < 4; ++k) { kro[k] = pir * 256 + (((map * 8 + k * 2 + hi) ^ (pir & 15)) * 16); vro[k] = AT_V0 + r32 * 128 + (((k * 2 + hi) ^ ((r32 >> 1) & 7)) * 16); }
    for (int u = cid; u < 1024; u += G) {
        const int w = u & 255, i = u >> 8, bh = (w & 7) * 4 + (w >> 6), r = (w >> 3) & 7, b = bh >> 3, h = bh & 7;
        const int j = (i >> 1) * 16 + ((i & 1) ? 15 - r : r);
        const int mychunk = 2 * j + (qg >> 1), qpos = j * 128 + qg * 32 + r32;
        float mb = 0.f;
        for (int k = 0; k < 32; ++k) mb = fmaxf(mb, fabsf(P->in[23][k * 8 + h]));
        const float smax2 = (8.f * mq * mk + mb) * LOG2E;
        __syncthreads();
        if (tid < 192) tb2[tid] = P->in[23][t5_bucket(tid - 128) * 8 + h] * LOG2E - smax2;
        bf16x8 qf[4];
        { const bf16_t* qp = Zq + ((size_t)b * SEQ + qpos) * 1024 + h * 128 + map * 64 + 8 * hi;
#pragma unroll
          for (int ks = 0; ks < 4; ++ks) qf[ks] = *(const bf16x8*)(qp + ks * 16); }
        f32x16 o[4];
#pragma unroll
        for (int et = 0; et < 4; ++et)
#pragma unroll
            for (int k = 0; k < 16; ++k) o[et][k] = 0.f;
        float lsum = 0.f;
        const bf16_t* kg[2]; const bf16_t* vg[2];
#pragma unroll
        for (int i2 = 0; i2 < 2; ++i2) { const int blk = wave * 2 + i2;
            { const int row = blk * 4 + (lane >> 4), c = (lane & 15) ^ (row & 15); kg[i2] = Zk + ((size_t)b * SEQ + row) * 1024 + h * 128 + c * 8; }
            { const int row = blk * 8 + (lane >> 3), c = (lane & 7) ^ ((row >> 1) & 7); vg[i2] = VT + ((size_t)bh * 128 + row) * SEQ + c * 8; } }
        const int dw = wave * 2048;
#define AT_LOADK(t) do { AT_DMA(kg[0] + (size_t)(t) * 65536, ldsl + ((t) & 1) * AT_KS + dw); AT_DMA(kg[1] + (size_t)(t) * 65536, ldsl + ((t) & 1) * AT_KS + dw + 1024); } while (0)
#define AT_LOADV(t) do { AT_DMA(vg[0] + (t) * 64, ldsl + AT_V0 + ((t) & 1) * AT_KS + dw); AT_DMA(vg[1] + (t) * 64, ldsl + AT_V0 + ((t) & 1) * AT_KS + dw + 1024); } while (0)
        AT_LOADK(0); AT_LOADV(0); AT_LOADK(1);
        __syncthreads();
        f32x16 sc0, sc1, sn0, sn1;
        attn_qk<true>(sc0, sc1, ldsl, kro, qf, 0 - mychunk, tb2, hi, qg, r32);
        const int nfar = 2 * j - 3;
        int kt = 0;
        for (; kt < nfar; ++kt) {
            AT_LOADK(kt + 2); AT_LOADV(kt + 1);
            attn_qk<false>(sn0, sn1, ldsl + ((kt + 1) & 1) * AT_KS, kro, qf, 0, tb2, hi, qg, r32);
            attn_pv(sc0, sc1, ldsl + (kt & 1) * AT_KS, vro, o, lsum);
            sc0 = sn0; sc1 = sn1;
            __syncthreads();
        }
        for (; kt < 2 * j; ++kt) {
            AT_LOADK(kt + 2); AT_LOADV(kt + 1);
            attn_qk<true>(sn0, sn1, ldsl + ((kt + 1) & 1) * AT_KS, kro, qf, kt + 1 - mychunk, tb2, hi, qg, r32);
            attn_pv(sc0, sc1, ldsl + (kt & 1) * AT_KS, vro, o, lsum);
            sc0 = sn0; sc1 = sn1;
            __syncthreads();
        }
        AT_LOADV(2 * j + 1);
        if (qg >= 2) attn_qk<true>(sn0, sn1, ldsl + AT_KS, kro, qf, 0, tb2, hi, qg, r32);
        attn_pv(sc0, sc1, ldsl, vro, o, lsum);
        __syncthreads();
        if (qg >= 2) attn_pv(sn0, sn1, ldsl + AT_KS, vro, o, lsum);
        __syncthreads();
        lsum += __shfl_xor(lsum, 32);
        const float inv = 1.f / lsum;
        if (map == 1) {
#pragma unroll
            for (int et = 0; et < 4; ++et)
#pragma unroll
                for (int k = 0; k < 16; ++k) OX[(qg * 64 + et * 16 + k) * 64 + lane] = o[et][k] * inv;
        }
        __syncthreads();
        if (map == 0) {
            float ssq = 0.f;
#pragma unroll
            for (int et = 0; et < 4; ++et)
#pragma unroll
                for (int k = 0; k < 16; ++k) { const float v = o[et][k] * inv - lam * OX[(qg * 64 + et * 16 + k) * 64 + lane]; o[et][k] = v; ssq += v * v; }
            ssq += __shfl_xor(ssq, 32);
            const float rs = rsqrtf(ssq * (1.f / 128.f) + 1e-5f) * (1.f - linit);
            bf16_t* op = YY + ((size_t)b * SEQ + qpos) * 2048 + 1024 + h * 128 + 4 * hi;
            const float* sw = P->in[19] + l * 128 + 4 * hi;
#pragma unroll
            for (int et = 0; et < 4; ++et)
#pragma unroll
                for (int g4 = 0; g4 < 4; ++g4) {
                    const f32x4 wv = *(const f32x4*)(sw + et * 32 + 8 * g4);
                    u32x2 wo; wo.x = pk_bf16(o[et][4 * g4] * rs * wv.x, o[et][4 * g4 + 1] * rs * wv.y); wo.y = pk_bf16(o[et][4 * g4 + 2] * rs * wv.z, o[et][4 * g4 + 3] * rs * wv.w);
                    *(u32x2*)(op + et * 32 + 8 * g4) = wo;
                }
        }
    }
    __syncthreads();
}


#define XB_TMO      128
#define XB_XCNT(j)  (256  + 64 * (j))
#define XB_XSUB(j)  (1280 + 64 * (j))
#define XB_XGEN(j)  (2304 + 64 * (j))
#define XB_TOP      3328
#define XB_TOPGEN   3392
#define XCD_BAR_WORDS 3456
#define XB_SPIN_CAP (1u << 18)

__device__ __forceinline__ unsigned xb_ld(unsigned* p)              { return __hip_atomic_load(p, __ATOMIC_RELAXED, __HIP_MEMORY_SCOPE_AGENT); }
__device__ __forceinline__ unsigned xb_add(unsigned* p, unsigned v) { return __hip_atomic_fetch_add(p, v, __ATOMIC_RELAXED, __HIP_MEMORY_SCOPE_AGENT); }
__device__ __forceinline__ unsigned xb_xcc_id() { return (unsigned)__builtin_amdgcn_s_getreg((3 << 11) | 20) & 0xFu; }
#define XB_SPIN(cond, bar) do { unsigned _sp = 0; while (cond) { __builtin_amdgcn_s_sleep(1); \
    if ((++_sp & 255u) == 0u) { if (xb_ld(&(bar)[XB_TMO])) break; if (_sp > XB_SPIN_CAP) { atomicAdd(&(bar)[XB_TMO], 1u); break; } } } } while (0)

struct XcdBarrier {
    unsigned* bar; unsigned x;
    volatile LAS unsigned* st;
};

__device__ __forceinline__ XcdBarrier xcd_barrier_post(unsigned* bar, volatile LAS unsigned* st) {
    XcdBarrier b; b.bar = bar; b.x = xb_xcc_id(); b.st = st;
    if (threadIdx.x == 0) (void)xb_add(&bar[XB_XCNT(b.x)], 1u);
    return b;
}
__device__ __forceinline__ void xcd_barrier_complete(unsigned* bar, unsigned x, unsigned& nloc, unsigned& nx) {
    const unsigned G = gridDim.x * gridDim.y * gridDim.z;
    unsigned sum, cnt, mine, sp = 0u;
    for (;;) {
        sum = 0u; cnt = 0u; mine = 0u;
#pragma unroll
        for (unsigned j = 0; j < 16; ++j) { const unsigned c = xb_ld(&bar[XB_XCNT(j)]); sum += c; cnt += (c > 0u) ? 1u : 0u; mine = (j == x) ? c : mine; }
        if (sum == G) break;
        __builtin_amdgcn_s_sleep(1);
        if ((++sp & 255u) == 0u) { if (xb_ld(&bar[XB_TMO])) break; if (sp > XB_SPIN_CAP) { atomicAdd(&bar[XB_TMO], 1u); break; } }
    }
    nloc = mine > 0u ? mine : 1u; nx = cnt > 0u ? cnt : 1u;
}

__device__ __forceinline__ void xcd_barrier(const XcdBarrier& b) {
    asm volatile("s_waitcnt vmcnt(0)" ::: "memory");
    __syncthreads();
    if (threadIdx.x == 0) {
        unsigned* bar = b.bar;
        __builtin_amdgcn_s_waitcnt(0);
        unsigned nloc = b.st[0], nx = b.st[1];
        if (nloc == 0u) { xcd_barrier_complete(bar, b.x, nloc, nx); b.st[0] = nloc; b.st[1] = nx; }
        const unsigned old = xb_add(&bar[XB_XSUB(b.x)], 1u);
        const unsigned gen = old / nloc;
        if (old + 1u == (gen + 1u) * nloc) {
            __builtin_amdgcn_fence(__ATOMIC_RELEASE, "agent");
            asm volatile("s_waitcnt vmcnt(0)" ::: "memory");
            const unsigned og = xb_add(&bar[XB_TOP], 1u);
            const unsigned tg = og / nx;
            if (og + 1u == (tg + 1u) * nx) xb_add(&bar[XB_TOPGEN], 1u);
            else XB_SPIN(xb_ld(&bar[XB_TOPGEN]) == tg, bar);
            __builtin_amdgcn_fence(__ATOMIC_ACQUIRE, "agent");
            xb_add(&bar[XB_XGEN(b.x)], 1u);
            asm volatile("s_waitcnt vmcnt(0)" ::: "memory");
        } else {
            XB_SPIN(xb_ld(&bar[XB_XGEN(b.x)]) == gen, bar);
            __builtin_amdgcn_fence(__ATOMIC_ACQUIRE, "agent");
            asm volatile("s_waitcnt vmcnt(0)" ::: "memory");
        }
    }
    __syncthreads();
}


#ifndef PHMASK
#define PHMASK 127
#endif
constexpr int PH_PER_LAYER = 8, N_PHASES = 16;
__global__ void __launch_bounds__(512, 2) mega_fwd(Params Pin) {
    extern __shared__ __attribute__((aligned(16))) unsigned char lds[];
    cg::grid_group grid = cg::this_grid();
    PG8_LAS unsigned char* ldsl = (PG8_LAS unsigned char*)lds;
    const int ph_lo = Pin.ph_lo, ph_hi = Pin.ph_hi;
    volatile LAS unsigned* misc = (volatile LAS unsigned*)((LAS unsigned char*)lds + LDS_MISC);
    if (threadIdx.x < 16) misc[threadIdx.x] = 0u;
    __syncthreads();
    XcdBarrier xbar = xcd_barrier_post((unsigned*)(Pin.ws + WS_CTL), misc);
    for (int ph = ph_lo; ph < ph_hi; ++ph) {
        const int l = ph >> 3, q = ph & 7;
        PP P = (PP)__builtin_amdgcn_kernarg_segment_ptr(); asm volatile("" : "+s"(P));
        unsigned char* ws = P->ws;
        int G = gridDim.x, cid = blockIdx.x; asm volatile("" : "+s"(G), "+s"(cid));
        u64* rowss = (u64*)(ws + WS_ROWSS);
        bf16_t* Z = (bf16_t*)(ws + WS_Z);
        bf16_t* XB = (bf16_t*)(ws + WS_XB);
        bf16_t* YY = (bf16_t*)(ws + WS_YY);
        bf16_t* MB = (bf16_t*)(ws + WS_MB);
        if (q == 0 && (PHMASK & 1)) {
            conv_phase(P, l, lds, G, cid);
        } else if (q == 1 && (PHMASK & 2)) {
            pg8::Gemm g{XB, (const bf16_t*)(ws + WS_WIN), MTOK, NIN, DM, DM, DM}; pg8::StaticOrder S; S.init(MTOK, NIN, G, cid);
            EpiIn E{Z, rowss + (size_t)(2 * l) * MTOK, (float*)(lds + 131072), P->in[13] + l * 64, P->in[14] + l * 64};
            pg8::gemm_phase(ldsl, g, S, E);
        } else if (q == 2 && (PHMASK & 4)) {
#ifdef NAIVE_SSM
            ssm_phase(P, l, lds, G, cid);
#else
            ssm_mfma_phase(P, l, lds, G, cid);
#endif
#ifdef NAIVE_ATTN
            attn_phase(P, l, lds, G, cid);
#else
            prep_phase(P, l, lds, G, cid);
#endif
        } else if (q == 3 && (PHMASK & 8)) {
            pg8::Gemm g{(const bf16_t*)(ws + WS_YG), (const bf16_t*)(ws + WS_WGLU), MTOK, 1024, 1024, 1024, 1024}; pg8::StaticOrder S; S.init(MTOK, 1024, G, cid);
            EpiGlu E{(const bf16_t*)(ws + WS_YG), P->in[12] + l * 1024, YY};
            pg8::gemm_phase(ldsl, g, S, E);
#ifndef NAIVE_ATTN
            attn_mfma_phase(P, l, lds, G, cid);
#endif
        } else if (q == 4 && (PHMASK & 16)) {
            for (int half = 0; half < 2; ++half) {
                pg8::Gemm g{YY + half * 1024, (const bf16_t*)(ws + WS_WM) + half * 1024, MTOK, DM, 1024, 2048, 2048}; pg8::StaticOrder S; S.init(MTOK, DM, G, cid);
                EpiMerge E{Z + (size_t)(4 + 2 * half) * ZBLK, MB, half};
                pg8::gemm_phase(ldsl, g, S, E);
                __syncthreads();
            }
        } else if ((q == 5 || q == 7) && (PHMASK & 32)) {
            const bool dn = (q == 7);
            pg8::Gemm g{dn ? (const bf16_t*)(ws + WS_ACT) : MB, (const bf16_t*)(ws + (dn ? WS_WDN : WS_WOUT)), MTOK, DM, dn ? DFF : DM, dn ? DFF : DM, dn ? DFF : DM};
            pg8::StaticOrder S; S.init(MTOK, DM, G, cid);
            const float* xold = (l == 0 && !dn) ? P->in[0] : P->out;
            const int emit = !(dn && l == 1);
            EpiRes E{xold, P->out, XB, rowss + (size_t)(2 * l + (dn ? 2 : 1)) * MTOK, emit};
            pg8::gemm_phase(ldsl, g, S, E);
        } else if (q == 6 && (PHMASK & 64)) {
            pg8::Gemm g{XB, (const bf16_t*)(ws + WS_WGU), MTOK, NGU, DM, DM, DM}; pg8::StaticOrder S; S.init(MTOK, NGU, G, cid);
            EpiUp E{rowss + (size_t)(2 * l + 1) * MTOK, (bf16_t*)(ws + WS_ACT)};
            pg8::gemm_phase(ldsl, g, S, E);
        }
        if (ph + 1 < ph_hi) { if (ph == ph_lo) grid.sync(); else xcd_barrier(xbar); }
    }
}

#ifndef MK_COOP
#define MK_COOP 1
#endif
extern "C" void kernel_launch(void* const* d_in, const int* in_sizes, int n_in, void* d_out, int out_size, void* d_ws, size_t ws_size, hipStream_t stream) {
    static int grid = 0;
    if (grid == 0) {
        if (n_in != 28 || out_size != MTOK * DM || ws_size < WS_END) { fprintf(stderr, "kernel_launch: unexpected shapes (n_in %d out %d ws %zu)\n", n_in, out_size, ws_size); grid = -1; return; }
        int dev = 0, cus = 0, per_cu = 0;
        hipGetDevice(&dev);
        hipDeviceGetAttribute(&cus, hipDeviceAttributeMultiprocessorCount, dev);
        hipFuncSetAttribute((const void*)mega_fwd, hipFuncAttributeMaxDynamicSharedMemorySize, LDS_BYTES);
        hipOccupancyMaxActiveBlocksPerMultiprocessor(&per_cu, (const void*)mega_fwd, 512, LDS_BYTES);
        if (per_cu < 1) { fprintf(stderr, "kernel_launch: occupancy query says %d blocks per CU\n", per_cu); per_cu = 1; }
        (void)hipGetLastError();
        grid = cus * 1;
    }
    if (grid < 0) return;
    if (hipMemsetAsync((char*)d_ws + WS_CTL, 0, CTL_BYTES, stream) != hipSuccess) { fprintf(stderr, "kernel_launch: memset of the barrier words failed\n"); return; }
    Params p{};
    for (int i = 0; i < 28; ++i) p.in[i] = (const float*)d_in[i];
    p.out = (float*)d_out; p.ws = (unsigned char*)d_ws;
#if MK_COOP
    p.ph_lo = 0; p.ph_hi = N_PHASES;
    void* args[] = {&p};
    hipError_t e = hipLaunchCooperativeKernel((const void*)mega_fwd, dim3(grid), dim3(512), args, LDS_BYTES, stream);
    if (e != hipSuccess) fprintf(stderr, "cooperative launch failed: %s (grid %d)\n", hipGetErrorString(e), grid);
#else
    for (int ph = 0; ph < N_PHASES; ++ph) {
        p.ph_lo = ph; p.ph_hi = ph + 1;
        hipLaunchKernelGGL(mega_fwd, dim3(grid), dim3(512), LDS_BYTES, stream, p);
    }
#endif
}
```
